# Optimizing an MI355X kernel written in HIP

```python
import jax, jax.numpy as jnp
from jax import lax
import numpy as np

D_MODEL = 1024
BATCH = 4
SEQ = 8192
DEPTH = 1

CHUNK = 64
SUB_CHUNK = 16
HG_DK = 128
HG_HEADS = D_MODEL // HG_DK
HG_DV = D_MODEL // HG_HEADS
HG_FD = HG_HEADS * HG_DK
HG_DI = HG_HEADS * HG_DV
LB_TAIL_LOGIT = 2.0
GM_BLOCK = 128
GM_WIDTH = D_MODEL
GM_GROUPS = 8
GM_CG = GM_WIDTH // GM_GROUPS
D_FF = -(-8 * D_MODEL // (3 * 256)) * 256
IN_WIDTH = 2 * HG_FD + 2 * HG_DI + 2 * GM_WIDTH + 2 * D_MODEL
IN_SPLITS = (HG_FD, 2 * HG_FD, 2 * HG_FD + HG_DI, 2 * HG_FD + 2 * HG_DI,
             2 * HG_FD + 2 * HG_DI + GM_WIDTH, 2 * HG_FD + 2 * HG_DI + 2 * GM_WIDTH,
             2 * HG_FD + 2 * HG_DI + 2 * GM_WIDTH + D_MODEL)
DEEPNORM_ALPHA = (2.0 * DEPTH) ** 0.25
DEEPNORM_BETA = (8.0 * DEPTH) ** -0.25
LN_EPS = 1e-5
RMS_EPS = 1e-6

kernel_name = "hybrid_hgrn2_gmlp_deepnorm_adaln_block"


def _layer_norm(x):
    x = x.astype(jnp.float32)
    xc = x - jnp.mean(x, axis=-1, keepdims=True)
    return xc * lax.rsqrt(jnp.mean(xc * xc, axis=-1, keepdims=True) + LN_EPS)


def _to_chunks(t, heads):
    b, s, _ = t.shape
    return t.reshape(b, s // CHUNK, CHUNK, heads, -1).transpose(0, 3, 1, 2, 4)


def hgrn2_mixer(zq, zf, zi, zg, lower_bound, norm_w):
    b_, s_, _ = zq.shape
    n_sub = CHUNK // SUB_CHUNK
    f = lower_bound + (1.0 - lower_bound) * jax.nn.sigmoid(zf.astype(jnp.float32))
    q = _to_chunks(jax.nn.silu(zq.astype(jnp.float32)), HG_HEADS)
    k = _to_chunks(1.0 - f, HG_HEADS)
    log_f = _to_chunks(jnp.log(f), HG_HEADS)
    v = _to_chunks(zi.astype(jnp.float32), HG_HEADS)
    cum = jnp.cumsum(log_f, axis=3)
    cum_last = cum[:, :, :, -1:, :]

    u_chunk = jnp.einsum('bhnlk,bhnlv->bhnkv', k * jnp.exp(cum_last - cum), v)
    decay = jnp.exp(cum_last[:, :, :, 0, :])

    def step(state, inp):
        dec, upd = inp
        return dec[..., None] * state + upd, state

    state0 = jnp.zeros((b_, HG_HEADS, HG_DK, HG_DV), jnp.float32)
    _, s_prev = lax.scan(step, state0, (jnp.moveaxis(decay, 2, 0), jnp.moveaxis(u_chunk, 2, 0)))
    s_prev = jnp.moveaxis(s_prev, 0, 2)
    o_inter = jnp.einsum('bhnlk,bhnkv->bhnlv', q * jnp.exp(cum), s_prev)

    shp = q.shape[:3] + (n_sub, SUB_CHUNK, HG_DK)
    ref = (cum - log_f)[:, :, :, ::SUB_CHUNK, :]
    q_sub = q.reshape(shp) * jnp.exp(cum.reshape(shp) - ref[:, :, :, :, None, :])
    key_pos = jnp.arange(CHUNK)
    sub_idx = jnp.arange(n_sub)
    key_ok = key_pos[None, :] < (sub_idx[:, None] + 1) * SUB_CHUNK
    expo = ref[:, :, :, :, None, :] - cum[:, :, :, None, :, :]
    k_sub = k[:, :, :, None] * jnp.exp(jnp.where(key_ok[:, :, None], expo, -jnp.inf))
    scores = jnp.einsum('bhnimk,bhnisk->bhnims', q_sub, k_sub)
    q_pos = sub_idx[:, None] * SUB_CHUNK + jnp.arange(SUB_CHUNK)[None, :]
    causal = key_pos[None, None, :] <= q_pos[:, :, None]
    scores = jnp.where(causal, scores, 0.0)
    o_intra = jnp.einsum('bhnims,bhnsv->bhnimv', scores, v).reshape(o_inter.shape)

    o = (o_inter + o_intra).transpose(0, 2, 3, 1, 4).reshape(b_, s_, HG_HEADS, HG_DV)
    o = o * lax.rsqrt(jnp.mean(o * o, axis=-1, keepdims=True) + RMS_EPS) * norm_w
    gate = jax.nn.silu(zg.astype(jnp.float32)).reshape(b_, s_, HG_HEADS, HG_DV)
    return (o * gate).reshape(b_, s_, HG_DI)


def gmlp_mixer(zu, zv, ln_w, ln_b, w_s, b_s):
    b_, s_, _ = zu.shape
    u = jax.nn.gelu(zu.astype(jnp.float32), approximate=False)
    v = jax.nn.gelu(zv.astype(jnp.float32), approximate=False)
    v = _layer_norm(v) * ln_w + ln_b
    v = v.reshape(b_, s_ // GM_BLOCK, GM_BLOCK, GM_GROUPS, GM_CG)
    pos = jnp.arange(GM_BLOCK) // CHUNK
    mask = pos[:, None] >= pos[None, :]
    w = jnp.where(mask[None], w_s, 0.0)
    sv = jnp.einsum('gts,bnsgc->bntgc', w, v) + b_s.T[None, None, :, :, None]
    return u * sv.reshape(b_, s_, GM_WIDTH)


def setup_inputs(seed: int = 0) -> dict:
    key = jax.random.key(seed)
    ks = jax.random.split(key, 24)

    def nrm(k, shape, scale):
        return jax.random.normal(k, shape, jnp.float32) * scale

    L = DEPTH
    return {
        "x": nrm(ks[0], (BATCH, SEQ, D_MODEL), 1.0),
        "c": nrm(ks[1], (BATCH, D_MODEL), 1.0),
        "w_ada": nrm(ks[2], (L, D_MODEL, 6 * D_MODEL), D_MODEL ** -0.5),
        "b_ada": nrm(ks[3], (L, 6 * D_MODEL), 0.01),
        "w_in": nrm(ks[4], (L, D_MODEL, IN_WIDTH), D_MODEL ** -0.5),
        "b_gate": nrm(ks[5], (L, 2, D_MODEL), 0.01),
        "hgrn_lb_logits": nrm(ks[6], (L + 1, HG_FD), 0.1).at[L].add(LB_TAIL_LOGIT),
        "hgrn_norm_w": 1.0 + nrm(ks[7], (L, HG_DV), 0.02),
        "w_proj_a": nrm(ks[8], (L, HG_DI, D_MODEL), HG_DI ** -0.5),
        "gmlp_ln_w": 1.0 + nrm(ks[9], (L, GM_WIDTH), 0.02),
        "gmlp_ln_b": nrm(ks[10], (L, GM_WIDTH), 0.02),
        "gmlp_ws": nrm(ks[11], (L, GM_GROUPS, GM_BLOCK, GM_BLOCK), GM_BLOCK ** -0.5),
        "gmlp_bs": 1.0 + nrm(ks[12], (L, GM_GROUPS, GM_BLOCK), 0.1),
        "w_proj_b": nrm(ks[13], (L, GM_WIDTH, D_MODEL), GM_WIDTH ** -0.5),
        "w_out": nrm(ks[14], (L, D_MODEL, D_MODEL), DEEPNORM_BETA * D_MODEL ** -0.5),
        "ln1_w": 1.0 + nrm(ks[15], (L, D_MODEL), 0.02),
        "ln1_b": nrm(ks[16], (L, D_MODEL), 0.02),
        "w_ffn_in": nrm(ks[17], (L, D_MODEL, 2 * D_FF), D_MODEL ** -0.5),
        "w_ffn_out": nrm(ks[18], (L, D_FF, D_MODEL), DEEPNORM_BETA * D_FF ** -0.5),
        "ln2_w": 1.0 + nrm(ks[19], (L, D_MODEL), 0.02),
        "ln2_b": nrm(ks[20], (L, D_MODEL), 0.02),
    }


def reference(x, c, w_ada, b_ada, w_in, b_gate, hgrn_lb_logits, hgrn_norm_w, w_proj_a,
              gmlp_ln_w, gmlp_ln_b, gmlp_ws, gmlp_bs, w_proj_b, w_out, ln1_w, ln1_b,
              w_ffn_in, w_ffn_out, ln2_w, ln2_b):
    lower_bounds = jnp.cumsum(jax.nn.softmax(hgrn_lb_logits.astype(jnp.float32), axis=0), axis=0)
    h = x.astype(jnp.float32)
    cond = jax.nn.silu(c.astype(jnp.float32))
    for l in range(DEPTH):
        mod = cond @ w_ada[l] + b_ada[l]
        sh1, sc1, g1, sh2, sc2, g2 = [m[:, None, :] for m in jnp.split(mod, 6, axis=-1)]

        u = _layer_norm(h) * (1.0 + sc1) + sh1
        z = u @ w_in[l]
        zq, zf, zi, zg, zu, zv, zga, zgb = jnp.split(z, IN_SPLITS, axis=-1)
        y_a = hgrn2_mixer(zq, zf, zi, zg, lower_bounds[l], hgrn_norm_w[l]) @ w_proj_a[l]
        y_b = gmlp_mixer(zu, zv, gmlp_ln_w[l], gmlp_ln_b[l], gmlp_ws[l], gmlp_bs[l]) @ w_proj_b[l]
        gate_a = jax.nn.sigmoid(zga + b_gate[l, 0])
        gate_b = jax.nn.sigmoid(zgb + b_gate[l, 1])
        mix = (gate_a * y_a + gate_b * y_b) @ w_out[l]
        h = _layer_norm(DEEPNORM_ALPHA * h + g1 * mix) * ln1_w[l] + ln1_b[l]

        u2 = _layer_norm(h) * (1.0 + sc2) + sh2
        a, bb = jnp.split(u2 @ w_ffn_in[l], 2, axis=-1)
        ffn = (jax.nn.silu(a) * bb) @ w_ffn_out[l]
        h = _layer_norm(DEEPNORM_ALPHA * h + g2 * ffn) * ln2_w[l] + ln2_b[l]
    return h.astype(x.dtype)
```

```cpp
#include <hip/hip_runtime.h>
#include <cstdio>
#include <cstdint>

#ifndef MK_N_LAUNCHES
#define MK_N_LAUNCHES 1
#endif

namespace pg8 {
#define PG8_LAS __attribute__((address_space(3)))
typedef unsigned short bf16_t;
typedef short bf16x8 __attribute__((ext_vector_type(8)));
typedef float f32x4 __attribute__((ext_vector_type(4)));
typedef unsigned u32x4 __attribute__((ext_vector_type(4)));
constexpr int BM = 256, BK = 64, HALF = 128, HTB = HALF * BK * 2, STAGE_BYTES = 8 * HTB, NXCD = 8, WGM = 8;

__host__ __device__ __forceinline__ int lds_byte(int r, int c) { const int st = (r >> 4) * 2 + (c >> 5), rr = r & 15, cc = c & 31, ob = rr * 64 + cc * 2; return st * 1024 + (ob ^ (((ob >> 9) & 1) << 5)); }
__host__ __device__ __forceinline__ void stage_rc(int b, int& R, int& C) { const int st = b / 1024, sb = b % 1024, swz = sb ^ (((sb >> 9) & 1) << 5); R = (st >> 1) * 16 + swz / 64; C = (st & 1) * 32 + (swz % 64) / 2; }
__host__ __device__ __forceinline__ int perm32(int rho) { const int n = rho >> 4, i = rho & 15; return 8 * (i >> 2) + 4 * n + (i & 3); }

struct Unit { int pm, pn, kind; };

struct TileOrder {
    int nM, nN, nwg, G, c;
    __device__ void init(int M, int N, int G_, int c_) { nM = M / BM; nN = N / BM; nwg = nM * nN; G = G_; c = c_; }
    __device__ bool tile(int i, int& pm, int& pn) const {
        const long L = (long)i * G + c; if (L >= nwg) return false;
        int wgid = (int)L; { const int q = nwg / NXCD, r = nwg % NXCD, xcd = wgid % NXCD, off = wgid / NXCD; wgid = (xcd < r ? xcd * (q + 1) : r * (q + 1) + (xcd - r) * q) + off; }
        const int nig = WGM * nN, gid = wgid / nig, fm = gid * WGM, gsz = (nM - fm) < WGM ? (nM - fm) : WGM;
        pm = fm + ((wgid % nig) % gsz); pn = (wgid % nig) / gsz; return true;
    }
};
struct SchedPlain {
    TileOrder T; const char* A; const char* Bt; size_t tstep;
    __device__ void init(const void* A_, const void* Bt_, int M, int N, int K, int G, int c) { T.init(M, N, G, c); A = (const char*)A_; Bt = (const char*)Bt_; tstep = (size_t)BM * K * 2; }
    __device__ __forceinline__ bool next(int i, Unit& u) const { u.kind = 0; return T.tile(i, u.pm, u.pn); }
    __device__ __forceinline__ const char* a_base(const Unit& u) const { return A + (size_t)u.pm * tstep; }
    __device__ __forceinline__ const char* b_base(const Unit& u) const { return Bt + (size_t)u.pn * tstep; }
};
struct SchedPair {
    TileOrder T; const char* A0; const char* B0; const char* A1; const char* B1; size_t tstep;
    __device__ void init(const void* A0_, const void* B0_, const void* A1_, const void* B1_, int M, int N, int K, int G, int c) { T.init(M, N, G, c); A0 = (const char*)A0_; B0 = (const char*)B0_; A1 = (const char*)A1_; B1 = (const char*)B1_; tstep = (size_t)BM * K * 2; }
    __device__ __forceinline__ bool next(int i, Unit& u) const { u.kind = i & 1; return T.tile(i >> 1, u.pm, u.pn); }
    __device__ __forceinline__ const char* a_base(const Unit& u) const { return (u.kind ? A1 : A0) + (size_t)u.pm * tstep; }
    __device__ __forceinline__ const char* b_base(const Unit& u) const { return (u.kind ? B1 : B0) + (size_t)u.pn * tstep; }
};

template <class Epi, class Sched, bool ALIGN_EPI = true>
__device__ __forceinline__ void gemm_phase(PG8_LAS unsigned char* lds, const int K, const Sched& S, const Epi& E) {
    const int tid = threadIdx.x, wid = __builtin_amdgcn_readfirstlane(tid >> 6), lane = tid & 63, wr = wid >> 2, wc = wid & 3, fr = lane & 15, fq = lane >> 4;
    const int nt = K / BK;
    unsigned voffA[2], voffB[2];
#pragma unroll
    for (int i = 0; i < 2; ++i) { int R, C; stage_rc(tid * 16 + i * 8192, R, C); const int Rb = Epi::PERM ? ((R & ~31) + perm32(R & 31)) : R;
        voffA[i] = (unsigned)(R * K + C) * 2u; voffB[i] = (unsigned)(Rb * K + C) * 2u; }
    const size_t kstep = (size_t)(BK * 2);
    const size_t hstep = (size_t)HALF * K * 2;
    const unsigned ldsw = (unsigned)wid * 1024u;
    const int aoff = lds_byte(wr * 64 + fr, fq * 8), boff = lds_byte(wc * 32 + fr, fq * 8);
#define PG8_SA(b, h) (((b) * 2 + (h)) * HTB)
#define PG8_SB(b, h) ((4 + (b) * 2 + (h)) * HTB)
#define PG8_STAGE(bufoff, gbase, voff) do { _Pragma("unroll") for (int _i = 0; _i < 2; ++_i) \
        __builtin_amdgcn_global_load_lds((const unsigned*)((const char*)(gbase) + (voff)[_i]), (PG8_LAS unsigned*)(lds + (bufoff) + ldsw + _i * 8192), 16, 0, 0); } while (0)
#define PG8_LDA(dst, b, h) do { _Pragma("unroll") for (int m = 0; m < 4; ++m) _Pragma("unroll") for (int k = 0; k < 2; ++k) dst[m][k] = *(const PG8_LAS bf16x8*)(lds + PG8_SA(b, h) + aoff + m * 2048 + k * 1024); } while (0)
#define PG8_LDB(dst, b, h) do { _Pragma("unroll") for (int n = 0; n < 2; ++n) _Pragma("unroll") for (int k = 0; k < 2; ++k) dst[n][k] = *(const PG8_LAS bf16x8*)(lds + PG8_SB(b, h) + boff + n * 2048 + k * 1024); } while (0)
#define PG8_MMA(ai, bj, At, Bt) do { __builtin_amdgcn_s_setprio(1); _Pragma("unroll") for (int m = 0; m < 4; ++m) _Pragma("unroll") for (int n = 0; n < 2; ++n) _Pragma("unroll") for (int k = 0; k < 2; ++k) \
        acc[ai][bj][m][n] = __builtin_amdgcn_mfma_f32_16x16x32_bf16(Bt[n][k], At[m][k], acc[ai][bj][m][n], 0, 0, 0); __builtin_amdgcn_s_setprio(0); } while (0)
#define PG8_WAIT_V(n) asm volatile("s_waitcnt vmcnt(" #n ")" ::: "memory")
#define PG8_WAIT_L(n) asm volatile("s_waitcnt lgkmcnt(" #n ")" ::: "memory")
#define PG8_BAR __builtin_amdgcn_s_barrier()
#define PG8_SCHED __builtin_amdgcn_sched_barrier(0)
    Unit cur, nxt; int ui = 0;
    if (!S.next(0, cur)) return;
    f32x4 acc[2][2][4][2];
#pragma unroll
    for (int a = 0; a < 2; ++a)
#pragma unroll
        for (int b = 0; b < 2; ++b)
#pragma unroll
            for (int m = 0; m < 4; ++m)
#pragma unroll
                for (int n = 0; n < 2; ++n) acc[a][b][m][n] = (f32x4){0.f, 0.f, 0.f, 0.f};
    bf16x8 At[4][2], B0[2][2], B1[2][2];
    const char* cA = S.a_base(cur); const char* cB = S.b_base(cur);
    PG8_STAGE(PG8_SB(0, 0), cB, voffB); PG8_STAGE(PG8_SB(0, 1), cB + hstep, voffB); PG8_STAGE(PG8_SA(0, 0), cA, voffA); PG8_STAGE(PG8_SA(0, 1), cA + hstep, voffA);
    if (wr == 1) PG8_BAR;
    PG8_WAIT_V(2); PG8_BAR;
    PG8_STAGE(PG8_SB(1, 0), cB + kstep, voffB); PG8_STAGE(PG8_SA(1, 0), cA + kstep, voffA); PG8_STAGE(PG8_SB(1, 1), cB + hstep + kstep, voffB);
    PG8_WAIT_V(6); PG8_BAR;
    for (;;) {
        const bool has_next = S.next(ui + 1, nxt);
        const char* nA = has_next ? S.a_base(nxt) : cA; const char* nB = has_next ? S.b_base(nxt) : cB;
        for (int t = 0; t < nt; t += 2) {
            const bool last = (t == nt - 2);
            const char* a1 = cA + (size_t)(t + 1) * kstep;
            const char* a2 = last ? nA : cA + (size_t)(t + 2) * kstep; const char* b2 = last ? nB : cB + (size_t)(t + 2) * kstep;
            const char* a3 = a2 + kstep; const char* b3 = b2 + kstep;
            PG8_LDB(B0, 0, 0); PG8_LDB(B1, 0, 1); PG8_SCHED; PG8_LDA(At, 0, 0); PG8_STAGE(PG8_SA(1, 1), a1 + hstep, voffA);
            PG8_WAIT_V(8); PG8_WAIT_L(0); PG8_BAR; PG8_MMA(0, 0, At, B0); PG8_MMA(0, 1, At, B1); PG8_BAR; PG8_SCHED;
            PG8_LDA(At, 0, 1); PG8_STAGE(PG8_SB(0, 0), b2, voffB); PG8_STAGE(PG8_SB(0, 1), b2 + hstep, voffB); PG8_STAGE(PG8_SA(0, 0), a2, voffA);
            PG8_WAIT_V(8); PG8_WAIT_L(0); PG8_BAR; PG8_MMA(1, 0, At, B0); PG8_MMA(1, 1, At, B1); PG8_BAR; PG8_SCHED;
            PG8_LDB(B0, 1, 0); PG8_LDB(B1, 1, 1); PG8_SCHED; PG8_LDA(At, 1, 0); PG8_STAGE(PG8_SA(0, 1), a2 + hstep, voffA);
            PG8_WAIT_V(8); PG8_WAIT_L(0); PG8_BAR; PG8_MMA(0, 0, At, B0); PG8_MMA(0, 1, At, B1); PG8_BAR; PG8_SCHED;
            PG8_LDA(At, 1, 1); PG8_STAGE(PG8_SB(1, 0), b3, voffB); PG8_STAGE(PG8_SB(1, 1), b3 + hstep, voffB); PG8_STAGE(PG8_SA(1, 0), a3, voffA);
            PG8_WAIT_V(8); PG8_WAIT_L(0); PG8_BAR; PG8_MMA(1, 0, At, B0); PG8_MMA(1, 1, At, B1); PG8_BAR; PG8_SCHED;
        }
        if constexpr (ALIGN_EPI) { if (wr == 0) PG8_BAR; }
        const bool keep = E(acc, cur, wr, wc, fr, fq);
        if (!has_next) break;
        if (!keep) {
#pragma unroll
            for (int a = 0; a < 2; ++a)
#pragma unroll
                for (int b = 0; b < 2; ++b)
#pragma unroll
                    for (int m = 0; m < 4; ++m)
#pragma unroll
                        for (int n = 0; n < 2; ++n) acc[a][b][m][n] = (f32x4){0.f, 0.f, 0.f, 0.f};
        }
        cur = nxt; cA = nA; cB = nB; ++ui;
        if constexpr (ALIGN_EPI) { if (wr == 1) PG8_BAR; }
    }
    PG8_WAIT_V(0);
    if constexpr (!ALIGN_EPI) { if (wr == 0) PG8_BAR; }
    PG8_BAR;
#undef PG8_SA
#undef PG8_SB
#undef PG8_STAGE
#undef PG8_LDA
#undef PG8_LDB
#undef PG8_MMA
#undef PG8_WAIT_V
#undef PG8_WAIT_L
#undef PG8_BAR
#undef PG8_SCHED
}
}

constexpr int NWAVES = 8;
constexpr int N_LAUNCHES = MK_N_LAUNCHES;
constexpr int PER_PHASE = 11;
constexpr int BATCH = 4, SEQ = 8192, D = 1024, NZ = 8192, DFF = 2816, NF1 = 2 * DFF;
constexpr int M = BATCH * SEQ;
constexpr float LN_EPS = 1e-5f, RMS_EPS = 1e-6f, ALPHA = 1.189207115002721f;
constexpr float LOG2E = 1.4426950408889634f;

constexpr size_t MiB = 1u << 20;
constexpr size_t WS_CTL = 0, CTL_ZERO_BYTES = 1 * MiB;
constexpr size_t WS_MODP = 1 * MiB;
constexpr size_t WS_MOD = 2 * MiB;
constexpr size_t WS_WIN = 4 * MiB, WS_WA = 20 * MiB, WS_WB = 22 * MiB, WS_WO = 24 * MiB, WS_WF1 = 26 * MiB, WS_WF2 = 37 * MiB, WS_WSG = 43 * MiB;
constexpr size_t WS_HST = 44 * MiB;
constexpr size_t WS_HDEC = 60 * MiB;
constexpr size_t WS_U = 64 * MiB;
constexpr size_t WS_ZQ = 128 * MiB, WS_ZF = 192 * MiB, WS_ZI = 256 * MiB, WS_ZG = 320 * MiB, WS_ZU = 384 * MiB, WS_ZV = 448 * MiB;
constexpr size_t WS_H1PRE = 192 * MiB;
constexpr size_t WS_H1 = 320 * MiB;
constexpr size_t WS_MIX = 448 * MiB;
constexpr size_t WS_ACT = 128 * MiB;
constexpr size_t WS_END = 512 * MiB;
constexpr int CW_TMO = 0, CW_CODE = 1, CW_BAR = 4096;

constexpr int RING_OFF = 0, RING_BYTES = 131072;
constexpr int LDSCTL_OFF = RING_BYTES, MISC_OFF = LDSCTL_OFF + 320;
constexpr int LDS_BYTES = 147456;

#define GAS __attribute__((address_space(1)))
#define LAS __attribute__((address_space(3)))
typedef unsigned short bf16;
typedef unsigned v4u __attribute__((ext_vector_type(4)));
typedef unsigned v2u __attribute__((ext_vector_type(2)));
typedef float f32x4 __attribute__((ext_vector_type(4)));
typedef float f32x2 __attribute__((ext_vector_type(2)));
typedef short bf16x8 __attribute__((ext_vector_type(8)));
typedef short bf16x4 __attribute__((ext_vector_type(4)));
typedef GAS unsigned gu32;
#define RLX_AGENT __ATOMIC_RELAXED, __HIP_MEMORY_SCOPE_AGENT
#define LDS_WAIT() asm volatile("s_waitcnt lgkmcnt(0)" ::: "memory")
#define VM_WAIT() asm volatile("s_waitcnt vmcnt(0)" ::: "memory")

__device__ __forceinline__ float bflo(unsigned w) { return __builtin_bit_cast(float, w << 16); }
__device__ __forceinline__ float bfhi(unsigned w) { return __builtin_bit_cast(float, w & 0xffff0000u); }
typedef __bf16 bf16x2_t __attribute__((ext_vector_type(2)));
__device__ __forceinline__ unsigned pk2(float lo, float hi) { f32x2 v = {lo, hi}; bf16x2_t b = __builtin_convertvector(v, bf16x2_t); return __builtin_bit_cast(unsigned, b); }
__device__ __forceinline__ float ex2(float x) { return __builtin_amdgcn_exp2f(x); }
__device__ __forceinline__ float lg2(float x) { return __builtin_amdgcn_logf(x); }
__device__ __forceinline__ float rcpf_(float x) { return __builtin_amdgcn_rcpf(x); }
__device__ __forceinline__ float sigmoidf_(float x) { return rcpf_(1.f + ex2(-x * LOG2E)); }
__device__ __forceinline__ float siluf_(float x) { return x * sigmoidf_(x); }
__device__ __forceinline__ float geluf_(float v) {
    const float av = __builtin_fabsf(v), t = rcpf_(av * 0.2316418882f + 1.0f);
    float q = t * 0.5307027145f + (-0.7265760135f); q = q * t + 0.7107068705f; q = q * t + (-0.142248368f); q = q * t + 0.127414796f; q = q * t;
    const float e = ex2((v * v) * (-0.72134752044f));
    const float m = v * (q * e);
    return v < 0.f ? m : v - m;
}
__device__ __forceinline__ float wave_sum(float v) {
#pragma unroll
    for (int o = 1; o < 64; o <<= 1) v += __shfl_xor(v, o);
    return v;
}

#define XB_TMO      128
#define XB_XCNT(j)  (256  + 64 * (j))
#define XB_XSUB(j)  (1280 + 64 * (j))
#define XB_XGEN(j)  (2304 + 64 * (j))
#define XB_TOP      3328
#define XB_TOPGEN   3392
#define XCD_BAR_WORDS 3456
#define XB_SPIN_CAP (1u << 18)
__device__ __forceinline__ unsigned xb_ld(unsigned* p)              { return __hip_atomic_load(p, __ATOMIC_RELAXED, __HIP_MEMORY_SCOPE_AGENT); }
__device__ __forceinline__ unsigned xb_add(unsigned* p, unsigned v) { return __hip_atomic_fetch_add(p, v, __ATOMIC_RELAXED, __HIP_MEMORY_SCOPE_AGENT); }
__device__ __forceinline__ unsigned xb_xcc_id() { return (unsigned)__builtin_amdgcn_s_getreg((3 << 11) | 20) & 0xFu; }
#define XB_SPIN(cond, bar) do { unsigned _sp = 0; while (cond) { __builtin_amdgcn_s_sleep(1); \
    if ((++_sp & 255u) == 0u) { if (xb_ld(&(bar)[XB_TMO])) break; if (_sp > XB_SPIN_CAP) { atomicAdd(&(bar)[XB_TMO], 1u); break; } } } } while (0)
struct XcdBarrier { unsigned* bar; unsigned x; volatile LAS unsigned* st; };
__device__ __forceinline__ XcdBarrier xcd_barrier_post(unsigned* bar, volatile LAS unsigned* st) {
    XcdBarrier b; b.bar = bar; b.x = xb_xcc_id(); b.st = st;
    if (threadIdx.x == 0) (void)xb_add(&bar[XB_XCNT(b.x)], 1u);
    return b;
}
__device__ __forceinline__ void xcd_barrier_complete(unsigned* bar, unsigned x, unsigned& nloc, unsigned& nx) {
    const unsigned G = gridDim.x * gridDim.y * gridDim.z;
    unsigned sum, cnt, mine, sp = 0u;
    for (;;) {
        sum = 0u; cnt = 0u; mine = 0u;
#pragma unroll
        for (unsigned j = 0; j < 16; ++j) { const unsigned c = xb_ld(&bar[XB_XCNT(j)]); sum += c; cnt += (c > 0u) ? 1u : 0u; mine = (j == x) ? c : mine; }
        if (sum == G) break;
        __builtin_amdgcn_s_sleep(1);
        if ((++sp & 255u) == 0u) { if (xb_ld(&bar[XB_TMO])) break; if (sp > XB_SPIN_CAP) { atomicAdd(&bar[XB_TMO], 1u); break; } }
    }
    nloc = mine > 0u ? mine : 1u; nx = cnt > 0u ? cnt : 1u;
}
__device__ __forceinline__ void xcd_barrier(const XcdBarrier& b) {
    asm volatile("s_waitcnt vmcnt(0)" ::: "memory");
    __syncthreads();
    if (threadIdx.x == 0) {
        unsigned* bar = b.bar;
        __builtin_amdgcn_s_waitcnt(0);
        unsigned nloc = b.st[0], nx = b.st[1];
        if (nloc == 0u) { xcd_barrier_complete(bar, b.x, nloc, nx); b.st[0] = nloc; b.st[1] = nx; }
        const unsigned old = xb_add(&bar[XB_XSUB(b.x)], 1u);
        const unsigned gen = old / nloc;
        if (old + 1u == (gen + 1u) * nloc) {
            __builtin_amdgcn_fence(__ATOMIC_RELEASE, "agent");
            asm volatile("s_waitcnt vmcnt(0)" ::: "memory");
            const unsigned og = xb_add(&bar[XB_TOP], 1u);
            const unsigned tg = og / nx;
            if (og + 1u == (tg + 1u) * nx) xb_add(&bar[XB_TOPGEN], 1u);
            else XB_SPIN(xb_ld(&bar[XB_TOPGEN]) == tg, bar);
            __builtin_amdgcn_fence(__ATOMIC_ACQUIRE, "agent");
            xb_add(&bar[XB_XGEN(b.x)], 1u);
            asm volatile("s_waitcnt vmcnt(0)" ::: "memory");
        } else {
            XB_SPIN(xb_ld(&bar[XB_XGEN(b.x)]) == gen, bar);
            __builtin_amdgcn_fence(__ATOMIC_ACQUIRE, "agent");
            asm volatile("s_waitcnt vmcnt(0)" ::: "memory");
        }
    }
    __syncthreads();
}

struct Frame {
    LAS unsigned char* lds;
    volatile LAS unsigned* MISC;
    gu32* ctl;
    int tid, lane, wave;
    int vcu, G;
    const float* in[21]; float* out; unsigned char* ws;
};
enum { I_X = 0, I_C, I_WADA, I_BADA, I_WIN, I_BGATE, I_LBL, I_HNW, I_WPA, I_GLNW, I_GLNB, I_GWS, I_GBS, I_WPB, I_WOUT, I_LN1W, I_LN1B, I_WF1, I_WF2, I_LN2W, I_LN2B };

__device__ __forceinline__ void p0_transpose_item(const float* W, int K, int N, bf16* WT, int dst_row0, LAS float* scr, int k0, int n0, int lane) {
#pragma unroll 8
    for (int i = 0; i < 32; ++i) { const int kk = 2 * i + (lane >> 5); scr[kk * 33 + (lane & 31)] = W[(size_t)(k0 + kk) * N + n0 + (lane & 31)]; }
    LDS_WAIT(); asm volatile("" ::: "memory");
    const int c = lane & 7;
#pragma unroll
    for (int j = 0; j < 4; ++j) { const int n = (lane >> 3) + 8 * j; const LAS float* s = scr + (8 * c) * 33 + n;
        v4u o; o.x = pk2(s[0 * 33], s[1 * 33]); o.y = pk2(s[2 * 33], s[3 * 33]); o.z = pk2(s[4 * 33], s[5 * 33]); o.w = pk2(s[6 * 33], s[7 * 33]);
        *(GAS v4u*)(WT + (size_t)(dst_row0 + n) * K + k0 + 8 * c) = o; }
    LDS_WAIT(); asm volatile("" ::: "memory");
}
__device__ __forceinline__ void p0_prologue(Frame& F) {
    LAS float* scr = (LAS float*)(F.lds + RING_OFF + F.wave * 16384);
    const int gw = F.vcu * NWAVES + F.wave, NGW = F.G * NWAVES, lane = F.lane;
    constexpr int I_IN = 16 * 256, I_SQ = 16 * 32, I_F1 = 16 * 176, I_F2 = 44 * 32, I_MOD = 768, I_WS = 128;
    constexpr int NITEMS = I_MOD + I_IN + 3 * I_SQ + I_F1 + I_F2 + I_WS;
    for (int it = gw; it < NITEMS; it += NGW) {
        int r = it;
        if (r < I_MOD) {
            const int cg = r % 96, ks = r / 96, col = 64 * cg + lane;
#pragma unroll
            for (int q = 0; q < 8; ++q) { const int idx = q * 64 + lane, b = idx >> 7, kk = idx & 127; scr[idx] = siluf_(F.in[I_C][b * D + ks * 128 + kk]); }
            LDS_WAIT(); asm volatile("" ::: "memory");
            float a0 = 0.f, a1 = 0.f, a2 = 0.f, a3 = 0.f;
            const float* w = F.in[I_WADA] + (size_t)(ks * 128) * 6144 + col;
#pragma unroll 8
            for (int kk = 0; kk < 128; ++kk) { const float wv = w[(size_t)kk * 6144]; a0 += scr[kk] * wv; a1 += scr[128 + kk] * wv; a2 += scr[256 + kk] * wv; a3 += scr[384 + kk] * wv; }
            float* mp = (float*)(F.ws + WS_MODP) + (size_t)(ks * 4) * 6144 + col;
            mp[0] = a0; mp[6144] = a1; mp[2 * 6144] = a2; mp[3 * 6144] = a3;
            LDS_WAIT(); asm volatile("" ::: "memory");
            continue;
        }
        r -= I_MOD;
        if (r < I_IN) { p0_transpose_item(F.in[I_WIN], D, NZ, (bf16*)(F.ws + WS_WIN), 32 * (r % 256), scr, 64 * (r / 256), 32 * (r % 256), lane); continue; } r -= I_IN;
        if (r < I_SQ) { p0_transpose_item(F.in[I_WPA], D, D, (bf16*)(F.ws + WS_WA), 32 * (r % 32), scr, 64 * (r / 32), 32 * (r % 32), lane); continue; } r -= I_SQ;
        if (r < I_SQ) { p0_transpose_item(F.in[I_WPB], D, D, (bf16*)(F.ws + WS_WB), 32 * (r % 32), scr, 64 * (r / 32), 32 * (r % 32), lane); continue; } r -= I_SQ;
        if (r < I_SQ) { p0_transpose_item(F.in[I_WOUT], D, D, (bf16*)(F.ws + WS_WO), 32 * (r % 32), scr, 64 * (r / 32), 32 * (r % 32), lane); continue; } r -= I_SQ;
        if (r < I_F1) {
            const int n0 = 32 * (r % 176), k0 = 64 * (r / 176);
            const int n1 = n0 < DFF ? n0 : n0 - DFF; const int dst = (n1 / 128) * 256 + (n0 < DFF ? 0 : 128) + (n1 % 128);
            p0_transpose_item(F.in[I_WF1], D, NF1, (bf16*)(F.ws + WS_WF1), dst, scr, k0, n0, lane); continue; } r -= I_F1;
        if (r < I_F2) { p0_transpose_item(F.in[I_WF2], DFF, D, (bf16*)(F.ws + WS_WF2), 32 * (r % 32), scr, 64 * (r / 32), 32 * (r % 32), lane); continue; } r -= I_F2;
        {
            const int e0 = r * 1024 + lane * 16; const float* src = F.in[I_GWS] + e0; unsigned o[8];
#pragma unroll
            for (int q = 0; q < 8; ++q) { const int e = e0 + 2 * q, s = e & 127, t = (e >> 7) & 127; const bool z = (t < 64) && (s >= 64); o[q] = z ? 0u : pk2(src[2 * q], src[2 * q + 1]); }
            GAS v4u* dst = (GAS v4u*)((bf16*)(F.ws + WS_WSG) + e0);
            dst[0] = (v4u){o[0], o[1], o[2], o[3]}; dst[1] = (v4u){o[4], o[5], o[6], o[7]};
        }
    }
}

__device__ __forceinline__ float mod_value(Frame& F, int b, int col) {
    const float* mp = (const float*)(F.ws + WS_MODP) + (size_t)b * 6144 + col; float s = F.in[I_BADA][col];
#pragma unroll
    for (int ks = 0; ks < 8; ++ks) s += mp[(size_t)ks * 4 * 6144];
    return s;
}
__device__ __forceinline__ void p1_adaln_in(Frame& F) {
    LAS float* tab = (LAS float*)(F.lds + RING_OFF);
    for (int wg = blockIdx.x; wg < M / 128; wg += F.G) {
        const int b = wg / (SEQ / 128);
        __syncthreads();
        for (int idx = F.tid; idx < 2048; idx += NWAVES * 64) { const float v = mod_value(F, b, idx); tab[idx] = idx < 1024 ? v : 1.f + v; }
        if (F.tid < 96) { const int bb = F.tid / 24, col = 24 * wg + F.tid % 24; ((float*)(F.ws + WS_MOD))[bb * 6144 + col] = mod_value(F, bb, col); }
        __syncthreads();
        for (int i = 0; i < 16; ++i) {
            const int row = wg * 128 + F.wave * 16 + i;
            const GAS f32x4* xr = (const GAS f32x4*)(F.in[I_X] + (size_t)row * D) + F.lane;
            f32x4 v[4]; float s = 0.f;
#pragma unroll
            for (int j = 0; j < 4; ++j) { v[j] = xr[64 * j]; s += (v[j].x + v[j].y) + (v[j].z + v[j].w); }
            const float mean = wave_sum(s) * (1.f / D); float s2 = 0.f;
#pragma unroll
            for (int j = 0; j < 4; ++j) { v[j] = v[j] - mean; s2 += (v[j].x * v[j].x + v[j].y * v[j].y) + (v[j].z * v[j].z + v[j].w * v[j].w); }
            const float rstd = __builtin_amdgcn_rsqf(wave_sum(s2) * (1.f / D) + LN_EPS);
            GAS v2u* o8 = (GAS v2u*)((bf16*)(F.ws + WS_U) + (size_t)row * D) + F.lane;
#pragma unroll
            for (int j = 0; j < 4; ++j) { const f32x4 sh = *(const LAS f32x4*)(tab + 4 * F.lane + 256 * j), sc = *(const LAS f32x4*)(tab + 1024 + 4 * F.lane + 256 * j);
                const f32x4 y = v[j] * rstd * sc + sh; o8[64 * j] = (v2u){pk2(y.x, y.y), pk2(y.z, y.w)}; }
        }
    }
}

struct EpiZ {
    static constexpr bool PERM = true;
    bf16* z0; bf16* zg;
    __device__ __forceinline__ bool operator()(f32x4 (&acc)[2][2][4][2], const pg8::Unit& u, int wr, int wc, int fr, int fq) const {
        const int t = u.pn >> 2; bf16* base = t < 6 ? z0 + (size_t)t * M * D : zg + (size_t)(t - 6) * M * D;
        const int row0 = u.pm * 256 + wr * 64 + fr, col0 = (u.pn & 3) * 256 + wc * 32 + 8 * fq;
#pragma unroll
        for (int ai = 0; ai < 2; ++ai)
#pragma unroll
            for (int m = 0; m < 4; ++m) { bf16* rowp = base + (size_t)(row0 + ai * 128 + m * 16) * D + col0;
#pragma unroll
                for (int bj = 0; bj < 2; ++bj) { const f32x4 v0 = acc[ai][bj][m][0], v1 = acc[ai][bj][m][1];
                    *(v4u*)(rowp + bj * 128) = (v4u){pk2(v0[0], v0[1]), pk2(v0[2], v0[3]), pk2(v1[0], v1[1]), pk2(v1[2], v1[3])}; } }
        return false;
    }
};
struct EpiProj {
    static constexpr bool PERM = true;
    const bf16* zga; const bf16* zgb; const float* bga; const float* bgb; bf16* mix;
    __device__ __forceinline__ bool operator()(f32x4 (&acc)[2][2][4][2], const pg8::Unit& u, int wr, int wc, int fr, int fq) const {
        const int row0 = u.pm * 256 + wr * 64 + fr, col0 = u.pn * 256 + wc * 32 + 8 * fq;
#pragma unroll
        for (int bj = 0; bj < 2; ++bj) {
            float ba[8], bb[8];
#pragma unroll
            for (int q = 0; q < 8; ++q) { ba[q] = bga[col0 + bj * 128 + q]; bb[q] = bgb[col0 + bj * 128 + q]; }
#pragma unroll
            for (int ai = 0; ai < 2; ++ai)
#pragma unroll
                for (int m = 0; m < 4; ++m) {
                    const size_t off = (size_t)(row0 + ai * 128 + m * 16) * D + col0 + bj * 128;
                    const v4u zb = *(const v4u*)(zgb + off);
                    float eb[8];
#pragma unroll
                    for (int q = 0; q < 4; ++q) { eb[2 * q] = ex2(-(bflo(zb[q]) + bb[2 * q]) * LOG2E); eb[2 * q + 1] = ex2(-(bfhi(zb[q]) + bb[2 * q + 1]) * LOG2E); }
                    if (u.kind == 0) {
                        const v4u za = *(const v4u*)(zga + off);
#pragma unroll
                        for (int q = 0; q < 4; ++q) {
                            const float ea0 = ex2(-(bflo(za[q]) + ba[2 * q]) * LOG2E), ea1 = ex2(-(bfhi(za[q]) + ba[2 * q + 1]) * LOG2E);
                            const float r0 = (1.f + eb[2 * q]) * rcpf_(1.f + ea0), r1 = (1.f + eb[2 * q + 1]) * rcpf_(1.f + ea1);
                            acc[ai][bj][m][q >> 1][2 * (q & 1)] *= r0; acc[ai][bj][m][q >> 1][2 * (q & 1) + 1] *= r1;
                        }
                    } else {
                        float o[8];
#pragma unroll
                        for (int q = 0; q < 8; ++q) o[q] = acc[ai][bj][m][q >> 2][q & 3] * rcpf_(1.f + eb[q]);
                        *(v4u*)(mix + off) = (v4u){pk2(o[0], o[1]), pk2(o[2], o[3]), pk2(o[4], o[5]), pk2(o[6], o[7])};
                    }
                }
        }
        return u.kind == 0;
    }
};
struct EpiRes {
    static constexpr bool PERM = false;
    const float* base; const float* gate  ; float* out;
    __device__ __forceinline__ bool operator()(f32x4 (&acc)[2][2][4][2], const pg8::Unit& u, int wr, int wc, int fr, int fq) const {
        const int row0 = u.pm * 256 + wr * 64 + fr, col0 = u.pn * 256 + wc * 32 + 4 * fq; const int b = (u.pm * 256) / SEQ;
        f32x4 gv[2][2];
#pragma unroll
        for (int bj = 0; bj < 2; ++bj)
#pragma unroll
            for (int n = 0; n < 2; ++n) gv[bj][n] = *(const f32x4*)(gate + (size_t)b * 6144 + col0 + bj * 128 + n * 16);
#pragma unroll
        for (int ai = 0; ai < 2; ++ai)
#pragma unroll
            for (int m = 0; m < 4; ++m) { const size_t off = (size_t)(row0 + ai * 128 + m * 16) * D + col0;
#pragma unroll
                for (int bj = 0; bj < 2; ++bj)
#pragma unroll
                    for (int n = 0; n < 2; ++n) { const f32x4 bs = *(const f32x4*)(base + off + bj * 128 + n * 16); *(f32x4*)(out + off + bj * 128 + n * 16) = bs * ALPHA + gv[bj][n] * acc[ai][bj][m][n]; }
                asm volatile("" ::: "memory"); }
        return false;
    }
};
struct EpiSwiGLU {
    static constexpr bool PERM = true;
    bf16* act;
    __device__ __forceinline__ bool operator()(f32x4 (&acc)[2][2][4][2], const pg8::Unit& u, int wr, int wc, int fr, int fq) const {
        const int row0 = u.pm * 256 + wr * 64 + fr, col0 = u.pn * 128 + wc * 32 + 8 * fq;
#pragma unroll
        for (int ai = 0; ai < 2; ++ai)
#pragma unroll
            for (int m = 0; m < 4; ++m) { float o[8];
#pragma unroll
                for (int q = 0; q < 8; ++q) { const float a = acc[ai][0][m][q >> 2][q & 3], bb = acc[ai][1][m][q >> 2][q & 3]; o[q] = siluf_(a) * bb; }
                *(v4u*)(act + (size_t)(row0 + ai * 128 + m * 16) * DFF + col0) = (v4u){pk2(o[0], o[1]), pk2(o[2], o[3]), pk2(o[4], o[5]), pk2(o[6], o[7])}; }
        return false;
    }
};

constexpr int HG_K1T = 0, HG_VT1 = 18432, HG_TOT1 = 36864, HG_DEC1 = 40960;
constexpr int HG_Q2 = 0, HG_K2 = 17408, HG_O = 0, HG_K2T = 34816, HG_VT = 53248, HG_SPT = 71680, HG_TOT = 106496, HG_E0 = 110592, HG_E1 = 111104;

__device__ __forceinline__ void hgrn_local_states(Frame& F) {
    LAS unsigned char* L = F.lds + RING_OFF;
    const int lane = F.lane, w = F.wave, fr = lane & 15, g = lane >> 4;
    for (int item = blockIdx.x; item < 256; item += F.G) {
        const int bh = item >> 3, j = item & 7, b = bh >> 3, h = bh & 7;
        const size_t row0 = (size_t)b * SEQ + (size_t)j * 1024;
        const int col = h * 128 + 2 * lane;
        const float* lbl = F.in[I_LBL];
        const float lb0 = rcpf_(1.f + ex2((lbl[1024 + col] - lbl[col]) * LOG2E)), lb1 = rcpf_(1.f + ex2((lbl[1024 + col + 1] - lbl[col + 1]) * LOG2E));
        const GAS unsigned* zf = (const GAS unsigned*)((const bf16*)(F.ws + WS_ZF) + (row0 + 8 * w) * D + col);
        const GAS unsigned* zi = (const GAS unsigned*)((const bf16*)(F.ws + WS_ZI) + (row0 + 8 * w) * D + col);
        f32x4 acc[8];
#pragma unroll
        for (int vb = 0; vb < 8; ++vb) acc[vb] = (f32x4){0.f, 0.f, 0.f, 0.f};
        float ds0 = 0.f, ds1 = 0.f;
        unsigned rf[8], ri[8], nf[8], ni[8];
#pragma unroll
        for (int i = 0; i < 8; ++i) { rf[i] = zf[(size_t)i * (D / 2)]; ri[i] = zi[(size_t)i * (D / 2)]; nf[i] = 0u; ni[i] = 0u; }
        __syncthreads();
        for (int n = 0; n < 16; ++n) {
            if (n + 1 < 16) {
#pragma unroll
                for (int i = 0; i < 8; ++i) { nf[i] = zf[(size_t)((n + 1) * 64 + i) * (D / 2)]; ni[i] = zi[(size_t)((n + 1) * 64 + i) * (D / 2)]; }
            }
            float f0[8], f1[8], c0[8], c1[8]; float r0 = 0.f, r1 = 0.f;
#pragma unroll
            for (int i = 0; i < 8; ++i) {
                f0[i] = lb0 + (1.f - lb0) * sigmoidf_(bflo(rf[i])); f1[i] = lb1 + (1.f - lb1) * sigmoidf_(bfhi(rf[i]));
                r0 += lg2(f0[i]); r1 += lg2(f1[i]); c0[i] = r0; c1[i] = r1;
            }
            *(LAS f32x2*)(L + HG_TOT1 + (w * 128 + 2 * lane) * 4) = (f32x2){r0, r1};
            __syncthreads();
            float p0 = 0.f, p1 = 0.f, a0 = 0.f, a1 = 0.f;
#pragma unroll
            for (int o = 0; o < 8; ++o) { const f32x2 t = *(const LAS f32x2*)(L + HG_TOT1 + (o * 128 + 2 * lane) * 4); a0 += t.x; a1 += t.y; if (o < w) { p0 += t.x; p1 += t.y; } }
            float k0[8], k1[8];
#pragma unroll
            for (int i = 0; i < 8; ++i) { k0[i] = (1.f - f0[i]) * ex2(a0 - p0 - c0[i]); k1[i] = (1.f - f1[i]) * ex2(a1 - p1 - c1[i]); }
            *(LAS v4u*)(L + HG_K1T + (2 * lane) * 144 + w * 16) = (v4u){pk2(k0[0], k0[1]), pk2(k0[2], k0[3]), pk2(k0[4], k0[5]), pk2(k0[6], k0[7])};
            *(LAS v4u*)(L + HG_K1T + (2 * lane + 1) * 144 + w * 16) = (v4u){pk2(k1[0], k1[1]), pk2(k1[2], k1[3]), pk2(k1[4], k1[5]), pk2(k1[6], k1[7])};
            *(LAS v4u*)(L + HG_VT1 + (2 * lane) * 144 + w * 16) = (v4u){(ri[0] & 0xffffu) | (ri[1] << 16), (ri[2] & 0xffffu) | (ri[3] << 16), (ri[4] & 0xffffu) | (ri[5] << 16), (ri[6] & 0xffffu) | (ri[7] << 16)};
            *(LAS v4u*)(L + HG_VT1 + (2 * lane + 1) * 144 + w * 16) = (v4u){(ri[0] >> 16) | (ri[1] & 0xffff0000u), (ri[2] >> 16) | (ri[3] & 0xffff0000u), (ri[4] >> 16) | (ri[5] & 0xffff0000u), (ri[6] >> 16) | (ri[7] & 0xffff0000u)};
            if (w == 0) *(LAS f32x2*)(L + HG_DEC1 + (2 * lane) * 4) = (f32x2){ex2(a0), ex2(a1)};
            ds0 += a0; ds1 += a1;
            __syncthreads();
            const f32x4 dec = *(const LAS f32x4*)(L + HG_DEC1 + (16 * w + 4 * g) * 4);
#pragma unroll
            for (int vb = 0; vb < 8; ++vb) acc[vb] = acc[vb] * dec;
#pragma unroll
            for (int ks = 0; ks < 2; ++ks) {
                const bf16x8 a = *(const LAS bf16x8*)(L + HG_K1T + (16 * w + fr) * 144 + 64 * ks + 16 * g);
#pragma unroll
                for (int vb = 0; vb < 8; ++vb) { const bf16x8 bv = *(const LAS bf16x8*)(L + HG_VT1 + (16 * vb + fr) * 144 + 64 * ks + 16 * g);
                    acc[vb] = __builtin_amdgcn_mfma_f32_16x16x32_bf16(a, bv, acc[vb], 0, 0, 0); }
            }
#pragma unroll
            for (int i = 0; i < 8; ++i) { rf[i] = nf[i]; ri[i] = ni[i]; }
        }
        GAS f32x4* hst = (GAS f32x4*)(F.ws + WS_HST) + ((size_t)(item * 8 + w) * 8) * 64 + lane;
#pragma unroll
        for (int vb = 0; vb < 8; ++vb) hst[vb * 64] = acc[vb];
        if (w == 0) *(GAS f32x2*)((float*)(F.ws + WS_HDEC) + item * 128 + 2 * lane) = (f32x2){ds0, ds1};
        __syncthreads();
    }
}

__device__ __forceinline__ void hgrn_outputs(Frame& F) {
    LAS unsigned char* L = F.lds + RING_OFF;
    const int lane = F.lane, w = F.wave, fr = lane & 15, g = lane >> 4, tb = w >> 1;
    for (int item = blockIdx.x; item < 256; item += F.G) {
        const int bh = item >> 3, j = item & 7, b = bh >> 3, h = bh & 7;
        const size_t row0 = (size_t)b * SEQ + (size_t)j * 1024;
        const int col = h * 128 + 2 * lane;
        const float* lbl = F.in[I_LBL];
        const float lb0 = rcpf_(1.f + ex2((lbl[1024 + col] - lbl[col]) * LOG2E)), lb1 = rcpf_(1.f + ex2((lbl[1024 + col + 1] - lbl[col + 1]) * LOG2E));
        const float nw0 = F.in[I_HNW][2 * lane], nw1 = F.in[I_HNW][2 * lane + 1];
        const GAS unsigned* zq = (const GAS unsigned*)((const bf16*)(F.ws + WS_ZQ) + (row0 + 8 * w) * D + col);
        const GAS unsigned* zf = (const GAS unsigned*)((const bf16*)(F.ws + WS_ZF) + (row0 + 8 * w) * D + col);
        const GAS unsigned* zi = (const GAS unsigned*)((const bf16*)(F.ws + WS_ZI) + (row0 + 8 * w) * D + col);
        const GAS unsigned* zg = (const GAS unsigned*)((const bf16*)(F.ws + WS_ZG) + (row0 + 8 * w) * D + col);
        GAS unsigned* hg = (GAS unsigned*)((bf16*)(F.ws + WS_ZQ) + (row0 + 8 * w) * D + col);
        f32x4 S[8];
#pragma unroll
        for (int vb = 0; vb < 8; ++vb) S[vb] = (f32x4){0.f, 0.f, 0.f, 0.f};
        for (int i = 0; i < j; ++i) {
            const int it2 = bh * 8 + i;
            const f32x4 dl = *(const GAS f32x4*)((const float*)(F.ws + WS_HDEC) + it2 * 128 + 16 * w + 4 * g);
            const f32x4 d4 = (f32x4){ex2(dl.x), ex2(dl.y), ex2(dl.z), ex2(dl.w)};
            const GAS f32x4* hst = (const GAS f32x4*)(F.ws + WS_HST) + ((size_t)(it2 * 8 + w) * 8) * 64 + lane;
#pragma unroll
            for (int vb = 0; vb < 8; ++vb) S[vb] = S[vb] * d4 + hst[vb * 64];
        }
        unsigned rq[8], rf[8], ri[8], rg[8];
#pragma unroll
        for (int i = 0; i < 8; ++i) { rq[i] = zq[(size_t)i * (D / 2)]; rf[i] = zf[(size_t)i * (D / 2)]; ri[i] = zi[(size_t)i * (D / 2)]; }
        __syncthreads();
        for (int n = 0; n < 16; ++n) {
#pragma unroll
            for (int i = 0; i < 8; ++i) rg[i] = zg[(size_t)(n * 64 + i) * (D / 2)];
            float f0[8], f1[8], c0[8], c1[8], q0[8], q1[8]; float r0 = 0.f, r1 = 0.f;
#pragma unroll
            for (int i = 0; i < 8; ++i) {
                f0[i] = lb0 + (1.f - lb0) * sigmoidf_(bflo(rf[i])); f1[i] = lb1 + (1.f - lb1) * sigmoidf_(bfhi(rf[i]));
                r0 += lg2(f0[i]); r1 += lg2(f1[i]); c0[i] = r0; c1[i] = r1;
                q0[i] = siluf_(bflo(rq[i])); q1[i] = siluf_(bfhi(rq[i]));
            }
            *(LAS f32x2*)(L + HG_TOT + (w * 128 + 2 * lane) * 4) = (f32x2){r0, r1};
            __syncthreads();
            float p0 = 0.f, p1 = 0.f, a0 = 0.f, a1 = 0.f, m0 = 0.f, m1 = 0.f;
#pragma unroll
            for (int o = 0; o < 8; ++o) { const f32x2 t = *(const LAS f32x2*)(L + HG_TOT + (o * 128 + 2 * lane) * 4); a0 += t.x; a1 += t.y; if (o < w) { p0 += t.x; p1 += t.y; } if (o < 4) { m0 += t.x; m1 += t.y; } }
            float k0[8], k1[8];
#pragma unroll
            for (int i = 0; i < 8; ++i) {
                const float d0 = p0 + c0[i] - m0, d1 = p1 + c1[i] - m1;
                const float Q0 = q0[i] * ex2(d0), Q1 = q1[i] * ex2(d1);
                k0[i] = (1.f - f0[i]) * ex2(-d0); k1[i] = (1.f - f1[i]) * ex2(-d1);
                *(LAS unsigned*)(L + HG_Q2 + (8 * w + i) * 272 + 4 * lane) = pk2(Q0, Q1);
                *(LAS unsigned*)(L + HG_K2 + (8 * w + i) * 272 + 4 * lane) = pk2(k0[i], k1[i]);
            }
            *(LAS v4u*)(L + HG_K2T + (2 * lane) * 144 + w * 16) = (v4u){pk2(k0[0], k0[1]), pk2(k0[2], k0[3]), pk2(k0[4], k0[5]), pk2(k0[6], k0[7])};
            *(LAS v4u*)(L + HG_K2T + (2 * lane + 1) * 144 + w * 16) = (v4u){pk2(k1[0], k1[1]), pk2(k1[2], k1[3]), pk2(k1[4], k1[5]), pk2(k1[6], k1[7])};
            *(LAS v4u*)(L + HG_VT + (2 * lane) * 144 + w * 16) = (v4u){(ri[0] & 0xffffu) | (ri[1] << 16), (ri[2] & 0xffffu) | (ri[3] << 16), (ri[4] & 0xffffu) | (ri[5] << 16), (ri[6] & 0xffffu) | (ri[7] << 16)};
            *(LAS v4u*)(L + HG_VT + (2 * lane + 1) * 144 + w * 16) = (v4u){(ri[0] >> 16) | (ri[1] & 0xffff0000u), (ri[2] >> 16) | (ri[3] & 0xffff0000u), (ri[4] >> 16) | (ri[5] & 0xffff0000u), (ri[6] >> 16) | (ri[7] & 0xffff0000u)};
            if (w == 0) { *(LAS f32x2*)(L + HG_E0 + (2 * lane) * 4) = (f32x2){ex2(m0), ex2(m1)}; *(LAS f32x2*)(L + HG_E1 + (2 * lane) * 4) = (f32x2){ex2(a0 - m0), ex2(a1 - m1)}; }
            if (n + 1 < 16) {
#pragma unroll
                for (int i = 0; i < 8; ++i) { rq[i] = zq[(size_t)((n + 1) * 64 + i) * (D / 2)]; rf[i] = zf[(size_t)((n + 1) * 64 + i) * (D / 2)]; ri[i] = zi[(size_t)((n + 1) * 64 + i) * (D / 2)]; }
            }
            __syncthreads();
            const f32x4 e0 = *(const LAS f32x4*)(L + HG_E0 + (16 * w + 4 * g) * 4), e1 = *(const LAS f32x4*)(L + HG_E1 + (16 * w + 4 * g) * 4);
#pragma unroll
            for (int vb = 0; vb < 8; ++vb) { S[vb] = S[vb] * e0; *(LAS v2u*)(L + HG_SPT + (16 * vb + fr) * 272 + 32 * w + 8 * g) = (v2u){pk2(S[vb].x, S[vb].y), pk2(S[vb].z, S[vb].w)}; }
            bf16x8 qf[4];
#pragma unroll
            for (int kk = 0; kk < 4; ++kk) qf[kk] = *(const LAS bf16x8*)(L + HG_Q2 + (16 * tb + fr) * 272 + 64 * kk + 16 * g);
            f32x4 st[4];
#pragma unroll
            for (int sb = 0; sb < 4; ++sb) { st[sb] = (f32x4){0.f, 0.f, 0.f, 0.f};
                if (sb <= tb) {
#pragma unroll
                    for (int kk = 0; kk < 4; ++kk) { const bf16x8 a = *(const LAS bf16x8*)(L + HG_K2 + (16 * sb + fr) * 272 + 64 * kk + 16 * g);
                        st[sb] = __builtin_amdgcn_mfma_f32_16x16x32_bf16(a, qf[kk], st[sb], 0, 0, 0); }
                    if (sb == tb) {
#pragma unroll
                        for (int r = 0; r < 4; ++r) st[sb][r] = (4 * g + r <= fr) ? st[sb][r] : 0.f;
                    }
                } }
            bf16x8 pf[2];
#pragma unroll
            for (int ks = 0; ks < 2; ++ks) { const v4u pw = (v4u){pk2(st[2 * ks].x, st[2 * ks].y), pk2(st[2 * ks].z, st[2 * ks].w), pk2(st[2 * ks + 1].x, st[2 * ks + 1].y), pk2(st[2 * ks + 1].z, st[2 * ks + 1].w)}; pf[ks] = __builtin_bit_cast(bf16x8, pw); }
#pragma unroll
            for (int ks = 0; ks < 2; ++ks) {
                const bf16x8 a = *(const LAS bf16x8*)(L + HG_K2T + (16 * w + fr) * 144 + 64 * ks + 16 * g);
#pragma unroll
                for (int vb = 0; vb < 8; ++vb) { const bf16x8 bv = *(const LAS bf16x8*)(L + HG_VT + (16 * vb + fr) * 144 + 64 * ks + 16 * g);
                    S[vb] = __builtin_amdgcn_mfma_f32_16x16x32_bf16(a, bv, S[vb], 0, 0, 0); }
            }
#pragma unroll
            for (int vb = 0; vb < 8; ++vb) S[vb] = S[vb] * e1;
            __syncthreads();
            f32x4 oa[4];
#pragma unroll
            for (int v4 = 0; v4 < 4; ++v4) { const int vb = 4 * (w & 1) + v4; oa[v4] = (f32x4){0.f, 0.f, 0.f, 0.f};
#pragma unroll
                for (int ks = 0; ks < 2; ++ks) if (2 * ks <= tb) {
                    const bf16x4 lo = *(const LAS bf16x4*)(L + HG_VT + (16 * vb + fr) * 144 + 64 * ks + 8 * g), hi = *(const LAS bf16x4*)(L + HG_VT + (16 * vb + fr) * 144 + 64 * ks + 32 + 8 * g);
                    const bf16x8 bv = __builtin_shufflevector(lo, hi, 0, 1, 2, 3, 4, 5, 6, 7);
                    oa[v4] = __builtin_amdgcn_mfma_f32_16x16x32_bf16(pf[ks], bv, oa[v4], 0, 0, 0); }
#pragma unroll
                for (int kk = 0; kk < 4; ++kk) { const bf16x8 bv = *(const LAS bf16x8*)(L + HG_SPT + (16 * vb + fr) * 272 + 64 * kk + 16 * g);
                    oa[v4] = __builtin_amdgcn_mfma_f32_16x16x32_bf16(qf[kk], bv, oa[v4], 0, 0, 0); }
            }
            __syncthreads();
#pragma unroll
            for (int v4 = 0; v4 < 4; ++v4) { const int vb = 4 * (w & 1) + v4;
#pragma unroll
                for (int r = 0; r < 4; ++r) *(LAS float*)(L + HG_O + ((16 * tb + 4 * g + r) * 132 + 16 * vb + fr) * 4) = oa[v4][r]; }
            __syncthreads();
#pragma unroll
            for (int i = 0; i < 8; ++i) {
                const f32x2 x = *(const LAS f32x2*)(L + HG_O + ((8 * w + i) * 132 + 2 * lane) * 4);
                const float rs = __builtin_amdgcn_rsqf(wave_sum(x.x * x.x + x.y * x.y) * (1.f / 128.f) + RMS_EPS);
                hg[(size_t)(n * 64 + i) * (D / 2)] = pk2(x.x * rs * nw0 * siluf_(bflo(rg[i])), x.y * rs * nw1 * siluf_(bfhi(rg[i])));
            }
        }
        __syncthreads();
    }
}

constexpr int GM_VNT = 0, GM_MU = 34816, GM_RS = 35328;
__device__ __forceinline__ void gmlp_phase(Frame& F) {
    LAS unsigned char* L = F.lds + RING_OFF;
    const int lane = F.lane, w = F.wave, fr = lane & 15, g4 = lane >> 4;
    for (int item = blockIdx.x; item < M / 128; item += F.G) {
        const size_t row0 = (size_t)item * 128;
        __syncthreads();
        for (int i = 0; i < 16; ++i) {
            GAS v4u* p = (GAS v4u*)((bf16*)(F.ws + WS_ZV) + (row0 + 16 * w + i) * D) + lane;
            float s = 0.f, ss = 0.f;
#pragma unroll
            for (int jj = 0; jj < 2; ++jj) { v4u x = p[64 * jj]; v4u o;
#pragma unroll
                for (int q = 0; q < 4; ++q) { const float y0 = geluf_(bflo(x[q])), y1 = geluf_(bfhi(x[q])); s += y0 + y1; ss += y0 * y0 + y1 * y1; o[q] = pk2(y0, y1); }
                p[64 * jj] = o; }
            s = wave_sum(s); ss = wave_sum(ss);
            const float mean = s * (1.f / D), var = ss * (1.f / D) - mean * mean;
            if (lane == 0) { *(LAS float*)(L + GM_MU + (16 * w + i) * 4) = mean; *(LAS float*)(L + GM_RS + (16 * w + i) * 4) = __builtin_amdgcn_rsqf(var + LN_EPS); }
        }
        __syncthreads();
        float mu[16], rs[16];
#pragma unroll
        for (int i = 0; i < 16; ++i) { mu[i] = *(const LAS float*)(L + GM_MU + (16 * w + i) * 4); rs[i] = *(const LAS float*)(L + GM_RS + (16 * w + i) * 4); }
        for (int gq = 0; gq < 8; ++gq) {
            const int col = gq * 128 + 2 * lane;
            const float lw0 = F.in[I_GLNW][col], lw1 = F.in[I_GLNW][col + 1], lb0 = F.in[I_GLNB][col], lb1 = F.in[I_GLNB][col + 1];
            const GAS unsigned* gv = (const GAS unsigned*)((const bf16*)(F.ws + WS_ZV) + (row0 + 16 * w) * D + col);
            unsigned n0[8], n1[8];
#pragma unroll
            for (int i = 0; i < 8; ++i) {
                const unsigned xa = gv[(size_t)(2 * i) * (D / 2)], xb = gv[(size_t)(2 * i + 1) * (D / 2)];
                const float a0 = (bflo(xa) - mu[2 * i]) * rs[2 * i] * lw0 + lb0, a1 = (bfhi(xa) - mu[2 * i]) * rs[2 * i] * lw1 + lb1;
                const float b0 = (bflo(xb) - mu[2 * i + 1]) * rs[2 * i + 1] * lw0 + lb0, b1 = (bfhi(xb) - mu[2 * i + 1]) * rs[2 * i + 1] * lw1 + lb1;
                n0[i] = pk2(a0, b0); n1[i] = pk2(a1, b1);
            }
            *(LAS v4u*)(L + GM_VNT + (2 * lane) * 272 + 32 * w) = (v4u){n0[0], n0[1], n0[2], n0[3]}; *(LAS v4u*)(L + GM_VNT + (2 * lane) * 272 + 32 * w + 16) = (v4u){n0[4], n0[5], n0[6], n0[7]};
            *(LAS v4u*)(L + GM_VNT + (2 * lane + 1) * 272 + 32 * w) = (v4u){n1[0], n1[1], n1[2], n1[3]}; *(LAS v4u*)(L + GM_VNT + (2 * lane + 1) * 272 + 32 * w + 16) = (v4u){n1[4], n1[5], n1[6], n1[7]};
            __syncthreads();
            f32x4 acc[8];
#pragma unroll
            for (int cb = 0; cb < 8; ++cb) acc[cb] = (f32x4){0.f, 0.f, 0.f, 0.f};
            const bf16* wsg = (const bf16*)(F.ws + WS_WSG) + (size_t)(gq * 128 + 16 * w + fr) * 128 + 8 * g4;
#pragma unroll
            for (int kk = 0; kk < 4; ++kk) {
                if (w < 4 && kk >= 2) continue;
                const bf16x8 a = *(const GAS bf16x8*)(wsg + 32 * kk);
#pragma unroll
                for (int cb = 0; cb < 8; ++cb) { const bf16x8 bv = *(const LAS bf16x8*)(L + GM_VNT + (16 * cb + fr) * 272 + 64 * kk + 16 * g4);
                    acc[cb] = __builtin_amdgcn_mfma_f32_16x16x32_bf16(a, bv, acc[cb], 0, 0, 0); }
            }
            const f32x4 bs = *(const GAS f32x4*)(F.in[I_GBS] + gq * 128 + 16 * w + 4 * g4);
#pragma unroll
            for (int cb = 0; cb < 8; ++cb)
#pragma unroll
                for (int r = 0; r < 4; ++r) {
                    GAS bf16* pu = (GAS bf16*)(F.ws + WS_ZU) + (row0 + 16 * w + 4 * g4 + r) * D + gq * 128 + 16 * cb + fr;
                    const float u = geluf_(__builtin_bit_cast(float, (unsigned)(*pu) << 16));
                    *pu = (bf16)(pk2(u * (acc[cb][r] + bs[r]), 0.f) & 0xffffu);
                }
            __syncthreads();
        }
    }
}

__device__ __forceinline__ void ln_mid_phase(Frame& F) {
    LAS float* tab = (LAS float*)(F.lds + RING_OFF);
    for (int wg = blockIdx.x; wg < M / 128; wg += F.G) {
        const int b = wg / (SEQ / 128);
        __syncthreads();
        const float* mod = (const float*)(F.ws + WS_MOD) + (size_t)b * 6144;
        for (int idx = F.tid; idx < 1024; idx += NWAVES * 64) { tab[idx] = F.in[I_LN1W][idx]; tab[1024 + idx] = F.in[I_LN1B][idx]; tab[2048 + idx] = mod[3072 + idx]; tab[3072 + idx] = 1.f + mod[4096 + idx]; }
        __syncthreads();
        for (int i = 0; i < 16; ++i) {
            const size_t row = (size_t)wg * 128 + F.wave * 16 + i;
            const GAS f32x4* xr = (const GAS f32x4*)((const float*)(F.ws + WS_H1PRE) + row * D) + F.lane;
            GAS f32x4* hr = (GAS f32x4*)((float*)(F.ws + WS_H1) + row * D) + F.lane;
            f32x4 v[4]; float s = 0.f;
#pragma unroll
            for (int j = 0; j < 4; ++j) { v[j] = xr[64 * j]; s += (v[j].x + v[j].y) + (v[j].z + v[j].w); }
            float mean = wave_sum(s) * (1.f / D), s2 = 0.f;
#pragma unroll
            for (int j = 0; j < 4; ++j) { v[j] = v[j] - mean; s2 += (v[j].x * v[j].x + v[j].y * v[j].y) + (v[j].z * v[j].z + v[j].w * v[j].w); }
            float rstd = __builtin_amdgcn_rsqf(wave_sum(s2) * (1.f / D) + LN_EPS);
            s = 0.f;
#pragma unroll
            for (int j = 0; j < 4; ++j) { const f32x4 lw = *(const LAS f32x4*)(tab + 4 * F.lane + 256 * j), lb = *(const LAS f32x4*)(tab + 1024 + 4 * F.lane + 256 * j);
                v[j] = v[j] * rstd * lw + lb; hr[64 * j] = v[j]; s += (v[j].x + v[j].y) + (v[j].z + v[j].w); }
            mean = wave_sum(s) * (1.f / D); s2 = 0.f;
#pragma unroll
            for (int j = 0; j < 4; ++j) { v[j] = v[j] - mean; s2 += (v[j].x * v[j].x + v[j].y * v[j].y) + (v[j].z * v[j].z + v[j].w * v[j].w); }
            rstd = __builtin_amdgcn_rsqf(wave_sum(s2) * (1.f / D) + LN_EPS);
            GAS v2u* o8 = (GAS v2u*)((bf16*)(F.ws + WS_U) + row * D) + F.lane;
#pragma unroll
            for (int j = 0; j < 4; ++j) { const f32x4 sh = *(const LAS f32x4*)(tab + 2048 + 4 * F.lane + 256 * j), sc = *(const LAS f32x4*)(tab + 3072 + 4 * F.lane + 256 * j);
                const f32x4 y = v[j] * rstd * sc + sh; o8[64 * j] = (v2u){pk2(y.x, y.y), pk2(y.z, y.w)}; }
        }
    }
}
__device__ __forceinline__ void ln_out_phase(Frame& F) {
    const int gw = blockIdx.x * NWAVES + F.wave, NGW = F.G * NWAVES;
    f32x4 lw[4], lb[4];
#pragma unroll
    for (int j = 0; j < 4; ++j) { lw[j] = *((const GAS f32x4*)F.in[I_LN2W] + F.lane + 64 * j); lb[j] = *((const GAS f32x4*)F.in[I_LN2B] + F.lane + 64 * j); }
    for (int row = gw; row < M; row += NGW) {
        GAS f32x4* xr = (GAS f32x4*)(F.out + (size_t)row * D) + F.lane;
        f32x4 v[4]; float s = 0.f;
#pragma unroll
        for (int j = 0; j < 4; ++j) { v[j] = xr[64 * j]; s += (v[j].x + v[j].y) + (v[j].z + v[j].w); }
        const float mean = wave_sum(s) * (1.f / D); float s2 = 0.f;
#pragma unroll
        for (int j = 0; j < 4; ++j) { v[j] = v[j] - mean; s2 += (v[j].x * v[j].x + v[j].y * v[j].y) + (v[j].z * v[j].z + v[j].w * v[j].w); }
        const float rstd = __builtin_amdgcn_rsqf(wave_sum(s2) * (1.f / D) + LN_EPS);
#pragma unroll
        for (int j = 0; j < 4; ++j) xr[64 * j] = v[j] * rstd * lw[j] + lb[j];
    }
}

struct Args { const float* in[21]; float* out; unsigned char* ws; int ph_lo, ph_hi, li, pad; };
__global__ void __launch_bounds__(NWAVES * 64, 2) mk_fwd(Args args) {
    extern __shared__ __attribute__((aligned(16))) unsigned char lds[];
    Frame F;
    F.lds = (LAS unsigned char*)lds;
    F.MISC = (volatile LAS unsigned*)(F.lds + MISC_OFF);
    F.tid = threadIdx.x; F.lane = F.tid & 63; F.wave = __builtin_amdgcn_readfirstlane(F.tid >> 6);
    F.G = gridDim.x; { const int bx = blockIdx.x; F.vcu = (F.G % 8 == 0) ? (bx % 8) * (F.G / 8) + bx / 8 : bx; }
    F.ws = args.ws; F.out = args.out; F.ctl = (gu32*)(args.ws + WS_CTL);
#pragma unroll
    for (int i = 0; i < 21; ++i) F.in[i] = args.in[i];
    for (int u = F.tid; u < (LDS_BYTES - LDSCTL_OFF) / 4; u += NWAVES * 64) ((LAS unsigned*)(F.lds + LDSCTL_OFF))[u] = 0u;
    __syncthreads();
    XcdBarrier bar; bar.bar = (unsigned*)(F.ctl + CW_BAR); bar.x = 0; bar.st = nullptr;
    if (N_LAUNCHES != PER_PHASE) bar = xcd_barrier_post((unsigned*)(F.ctl + CW_BAR) + args.li * XCD_BAR_WORDS, F.MISC + 8);
#define GRID_BAR(seam) do { if (N_LAUNCHES == PER_PHASE) { if (F.tid == 0) __hip_atomic_store(F.ctl + CW_TMO, 0xBADBA0u | (unsigned)(seam), RLX_AGENT); } else { xcd_barrier(bar); } } while (0)
    const int lo = args.ph_lo, hi = args.ph_hi;
#define IN(k) (lo <= (k) && (k) < hi)
#define BOTH(k) (IN(k) && IN((k) + 1))

    if (IN(0)) { p0_prologue(F); if (BOTH(0)) GRID_BAR(0); }
    if (IN(1)) { p1_adaln_in(F); if (BOTH(1)) GRID_BAR(1); }
    if (IN(2)) {
        pg8::SchedPlain S; S.init(F.ws + WS_U, F.ws + WS_WIN, M, NZ, D, F.G, (int)blockIdx.x);
        EpiZ E{(bf16*)(F.ws + WS_ZQ), (bf16*)F.out};
        pg8::gemm_phase<EpiZ, pg8::SchedPlain>(F.lds + RING_OFF, D, S, E);
        if (BOTH(2)) GRID_BAR(2);
    }
    if (IN(3)) { hgrn_local_states(F); gmlp_phase(F); if (BOTH(3)) GRID_BAR(3); }
    if (IN(4)) { hgrn_outputs(F); if (BOTH(4)) GRID_BAR(4); }
    if (IN(5)) {
        pg8::SchedPair S; S.init(F.ws + WS_ZQ, F.ws + WS_WA, F.ws + WS_ZU, F.ws + WS_WB, M, D, D, F.G, (int)blockIdx.x);
        EpiProj E{(const bf16*)F.out, (const bf16*)F.out + (size_t)M * D, F.in[I_BGATE], F.in[I_BGATE] + D, (bf16*)(F.ws + WS_MIX)};
        pg8::gemm_phase<EpiProj, pg8::SchedPair>(F.lds + RING_OFF, D, S, E);
        if (BOTH(5)) GRID_BAR(5);
    }
    if (IN(6)) {
        pg8::SchedPlain S; S.init(F.ws + WS_MIX, F.ws + WS_WO, M, D, D, F.G, (int)blockIdx.x);
        EpiRes E{F.in[I_X], (const float*)(F.ws + WS_MOD) + 2048, (float*)(F.ws + WS_H1PRE)};
        pg8::gemm_phase<EpiRes, pg8::SchedPlain>(F.lds + RING_OFF, D, S, E);
        if (BOTH(6)) GRID_BAR(6);
    }
    if (IN(7)) { ln_mid_phase(F); if (BOTH(7)) GRID_BAR(7); }
    if (IN(8)) {
        pg8::SchedPlain S; S.init(F.ws + WS_U, F.ws + WS_WF1, M, NF1, D, F.G, (int)blockIdx.x);
        EpiSwiGLU E{(bf16*)(F.ws + WS_ACT)};
        pg8::gemm_phase<EpiSwiGLU, pg8::SchedPlain>(F.lds + RING_OFF, D, S, E);
        if (BOTH(8)) GRID_BAR(8);
    }
    if (IN(9)) {
        pg8::SchedPlain S; S.init(F.ws + WS_ACT, F.ws + WS_WF2, M, D, DFF, F.G, (int)blockIdx.x);
        EpiRes E{(const float*)(F.ws + WS_H1), (const float*)(F.ws + WS_MOD) + 5120, F.out};
        pg8::gemm_phase<EpiRes, pg8::SchedPlain>(F.lds + RING_OFF, DFF, S, E);
        if (BOTH(9)) GRID_BAR(9);
    }
    if (IN(10)) { ln_out_phase(F); }
#undef IN
#undef BOTH
}

extern "C" void kernel_launch(void* const* d_in, const int* in_sizes, int n_in, void* d_out, int out_size, void* d_ws, size_t ws_size, hipStream_t stream) {
    static int grid = 0;
    if (grid == 0) {
        if (n_in != 21 || in_sizes[0] != M * D || out_size != M * D || ws_size < WS_END) { fprintf(stderr, "kernel_launch: unexpected shapes (n_in %d, in0 %d, out %d, ws %zu); nothing launched\n", n_in, n_in > 0 ? in_sizes[0] : -1, out_size, ws_size); grid = -1; return; }
        int dev = 0, cus = 0, per_cu = 0;
        if (hipGetDevice(&dev) != hipSuccess || hipDeviceGetAttribute(&cus, hipDeviceAttributeMultiprocessorCount, dev) != hipSuccess) { grid = -1; return; }
        if (hipFuncSetAttribute((const void*)mk_fwd, hipFuncAttributeMaxDynamicSharedMemorySize, LDS_BYTES) != hipSuccess) { fprintf(stderr, "kernel_launch: hipFuncSetAttribute failed\n"); grid = -1; return; }
        if (hipOccupancyMaxActiveBlocksPerMultiprocessor(&per_cu, (const void*)mk_fwd, NWAVES * 64, LDS_BYTES) != hipSuccess || per_cu < 1) fprintf(stderr, "kernel_launch: occupancy query reports %d workgroups per CU\n", per_cu);
        (void)hipGetLastError();
        grid = cus;
    }
    if (grid < 0) return;
    if (hipMemsetAsync((char*)d_ws + WS_CTL, 0, CTL_ZERO_BYTES, stream) != hipSuccess) return;
    Args a{};
    for (int i = 0; i < 21; ++i) a.in[i] = (const float*)d_in[i];
    a.out = (float*)d_out; a.ws = (unsigned char*)d_ws;
    for (int li = 0; li < N_LAUNCHES; ++li) {
        if (N_LAUNCHES == PER_PHASE) { a.ph_lo = li; a.ph_hi = li + 1; } else { a.ph_lo = 0; a.ph_hi = PER_PHASE; }
        a.li = (N_LAUNCHES == PER_PHASE) ? 0 : li;
        hipLaunchKernelGGL(mk_fwd, dim3(grid), dim3(NWAVES * 64), LDS_BYTES, stream, a);
        if (hipPeekAtLastError() != hipSuccess) { fprintf(stderr, "kernel_launch: launch %d failed\n", li); break; }
    }
}
```

```cpp
#include <hip/hip_runtime.h>
#include <cstdio>
#include <cstdint>

#ifndef MK_REPEAT
#define MK_REPEAT -1
#endif
#ifndef MK_TP_LO
#define MK_TP_LO -1
#define MK_TP_HI -1
#endif
#ifndef MK_TACC
#define MK_TACC -1
#endif
#ifndef MK_VARIANT
#define MK_VARIANT 0
#endif
#ifndef MK_N_LAUNCHES
#define MK_N_LAUNCHES 1
#endif

namespace pg8 {
#define PG8_LAS __attribute__((address_space(3)))
typedef unsigned short bf16_t;
typedef short bf16x8 __attribute__((ext_vector_type(8)));
typedef float f32x4 __attribute__((ext_vector_type(4)));
typedef unsigned u32x4 __attribute__((ext_vector_type(4)));
constexpr int BM = 256, BK = 64, HALF = 128, HTB = HALF * BK * 2, STAGE_BYTES = 8 * HTB, NXCD = 8, WGM = 8;

__host__ __device__ __forceinline__ int lds_byte(int r, int c) { const int st = (r >> 4) * 2 + (c >> 5), rr = r & 15, cc = c & 31, ob = rr * 64 + cc * 2; return st * 1024 + (ob ^ (((ob >> 9) & 1) << 5)); }
__host__ __device__ __forceinline__ void stage_rc(int b, int& R, int& C) { const int st = b / 1024, sb = b % 1024, swz = sb ^ (((sb >> 9) & 1) << 5); R = (st >> 1) * 16 + swz / 64; C = (st & 1) * 32 + (swz % 64) / 2; }
__host__ __device__ __forceinline__ int perm32(int rho) { const int n = rho >> 4, i = rho & 15; return 8 * (i >> 2) + 4 * n + (i & 3); }

struct Unit { int pm, pn, kind; };

struct TileOrder {
    int nM, nN, nwg, G, c;
    __device__ void init(int M, int N, int G_, int c_) { nM = M / BM; nN = N / BM; nwg = nM * nN; G = G_; c = c_; }
    __device__ bool tile(int i, int& pm, int& pn) const {
        const long L = (long)i * G + c; if (L >= nwg) return false;
        int wgid = (int)L; { const int q = nwg / NXCD, r = nwg % NXCD, xcd = wgid % NXCD, off = wgid / NXCD; wgid = (xcd < r ? xcd * (q + 1) : r * (q + 1) + (xcd - r) * q) + off; }
        const int nig = WGM * nN, gid = wgid / nig, fm = gid * WGM, gsz = (nM - fm) < WGM ? (nM - fm) : WGM;
        pm = fm + ((wgid % nig) % gsz); pn = (wgid % nig) / gsz; return true;
    }
};
struct SchedPlain {
    TileOrder T; const char* A; const char* Bt; size_t tstep;
    __device__ void init(const void* A_, const void* Bt_, int M, int N, int K, int G, int c) { T.init(M, N, G, c); A = (const char*)A_; Bt = (const char*)Bt_; tstep = (size_t)BM * K * 2; }
    __device__ __forceinline__ bool next(int i, Unit& u) const { u.kind = 0; return T.tile(i, u.pm, u.pn); }
    __device__ __forceinline__ const char* a_base(const Unit& u) const { return A + (size_t)u.pm * tstep; }
    __device__ __forceinline__ const char* b_base(const Unit& u) const { return Bt + (size_t)u.pn * tstep; }
};
struct SchedPair {
    TileOrder T; const char* A0; const char* B0; const char* A1; const char* B1; size_t tstep;
    __device__ void init(const void* A0_, const void* B0_, const void* A1_, const void* B1_, int M, int N, int K, int G, int c) { T.init(M, N, G, c); A0 = (const char*)A0_; B0 = (const char*)B0_; A1 = (const char*)A1_; B1 = (const char*)B1_; tstep = (size_t)BM * K * 2; }
    __device__ __forceinline__ bool next(int i, Unit& u) const { u.kind = i & 1; return T.tile(i >> 1, u.pm, u.pn); }
    __device__ __forceinline__ const char* a_base(const Unit& u) const { return (u.kind ? A1 : A0) + (size_t)u.pm * tstep; }
    __device__ __forceinline__ const char* b_base(const Unit& u) const { return (u.kind ? B1 : B0) + (size_t)u.pn * tstep; }
};

template <class Epi, class Sched, bool ALIGN_EPI = true>
__device__ __forceinline__ void gemm_phase(PG8_LAS unsigned char* lds, const int K, const Sched& S, const Epi& E) {
    const int tid = threadIdx.x, wid = __builtin_amdgcn_readfirstlane(tid >> 6), lane = tid & 63, wr = wid >> 2, wc = wid & 3, fr = lane & 15, fq = lane >> 4;
    const int nt = K / BK;
    unsigned voffA[2], voffB[2];
#pragma unroll
    for (int i = 0; i < 2; ++i) { int R, C; stage_rc(tid * 16 + i * 8192, R, C); const int Rb = Epi::PERM ? ((R & ~31) + perm32(R & 31)) : R;
        voffA[i] = (unsigned)(R * K + C) * 2u; voffB[i] = (unsigned)(Rb * K + C) * 2u; }
    const size_t kstep = (size_t)(BK * 2);
    const size_t hstep = (size_t)HALF * K * 2;
    const unsigned ldsw = (unsigned)wid * 1024u;
    const int aoff = lds_byte(wr * 64 + fr, fq * 8), boff = lds_byte(wc * 32 + fr, fq * 8);
#define PG8_SA(b, h) (((b) * 2 + (h)) * HTB)
#define PG8_SB(b, h) ((4 + (b) * 2 + (h)) * HTB)
#define PG8_STAGE(bufoff, gbase, voff) do { _Pragma("unroll") for (int _i = 0; _i < 2; ++_i) \
        __builtin_amdgcn_global_load_lds((const unsigned*)((const char*)(gbase) + (voff)[_i]), (PG8_LAS unsigned*)(lds + (bufoff) + ldsw + _i * 8192), 16, 0, 0); } while (0)
#define PG8_LDA(dst, b, h) do { _Pragma("unroll") for (int m = 0; m < 4; ++m) _Pragma("unroll") for (int k = 0; k < 2; ++k) dst[m][k] = *(const PG8_LAS bf16x8*)(lds + PG8_SA(b, h) + aoff + m * 2048 + k * 1024); } while (0)
#define PG8_LDB(dst, b, h) do { _Pragma("unroll") for (int n = 0; n < 2; ++n) _Pragma("unroll") for (int k = 0; k < 2; ++k) dst[n][k] = *(const PG8_LAS bf16x8*)(lds + PG8_SB(b, h) + boff + n * 2048 + k * 1024); } while (0)
#define PG8_MMA(ai, bj, At, Bt) do { __builtin_amdgcn_s_setprio(1); _Pragma("unroll") for (int m = 0; m < 4; ++m) _Pragma("unroll") for (int n = 0; n < 2; ++n) _Pragma("unroll") for (int k = 0; k < 2; ++k) \
        acc[ai][bj][m][n] = __builtin_amdgcn_mfma_f32_16x16x32_bf16(Bt[n][k], At[m][k], acc[ai][bj][m][n], 0, 0, 0); __builtin_amdgcn_s_setprio(0); } while (0)
#define PG8_WAIT_V(n) asm volatile("s_waitcnt vmcnt(" #n ")" ::: "memory")
#define PG8_WAIT_L(n) asm volatile("s_waitcnt lgkmcnt(" #n ")" ::: "memory")
#define PG8_BAR __builtin_amdgcn_s_barrier()
#define PG8_SCHED __builtin_amdgcn_sched_barrier(0)
    Unit cur, nxt; int ui = 0;
    if (!S.next(0, cur)) return;
    f32x4 acc[2][2][4][2];
#pragma unroll
    for (int a = 0; a < 2; ++a)
#pragma unroll
        for (int b = 0; b < 2; ++b)
#pragma unroll
            for (int m = 0; m < 4; ++m)
#pragma unroll
                for (int n = 0; n < 2; ++n) acc[a][b][m][n] = (f32x4){0.f, 0.f, 0.f, 0.f};
    bf16x8 At[4][2], B0[2][2], B1[2][2];
    const char* cA = S.a_base(cur); const char* cB = S.b_base(cur);
    PG8_STAGE(PG8_SB(0, 0), cB, voffB); PG8_STAGE(PG8_SB(0, 1), cB + hstep, voffB); PG8_STAGE(PG8_SA(0, 0), cA, voffA); PG8_STAGE(PG8_SA(0, 1), cA + hstep, voffA);
    if (wr == 1) PG8_BAR;
    PG8_WAIT_V(2); PG8_BAR;
    PG8_STAGE(PG8_SB(1, 0), cB + kstep, voffB); PG8_STAGE(PG8_SA(1, 0), cA + kstep, voffA); PG8_STAGE(PG8_SB(1, 1), cB + hstep + kstep, voffB);
    PG8_WAIT_V(6); PG8_BAR;
    for (;;) {
        const bool has_next = S.next(ui + 1, nxt);
        const char* nA = has_next ? S.a_base(nxt) : cA; const char* nB = has_next ? S.b_base(nxt) : cB;
        for (int t = 0; t < nt; t += 2) {
            const bool last = (t == nt - 2);
            const char* a1 = cA + (size_t)(t + 1) * kstep;
            const char* a2 = last ? nA : cA + (size_t)(t + 2) * kstep; const char* b2 = last ? nB : cB + (size_t)(t + 2) * kstep;
            const char* a3 = a2 + kstep; const char* b3 = b2 + kstep;
            PG8_LDB(B0, 0, 0); PG8_LDB(B1, 0, 1); PG8_SCHED; PG8_LDA(At, 0, 0); PG8_STAGE(PG8_SA(1, 1), a1 + hstep, voffA);
            PG8_WAIT_V(8); PG8_WAIT_L(0); PG8_BAR; PG8_MMA(0, 0, At, B0); PG8_MMA(0, 1, At, B1); PG8_BAR; PG8_SCHED;
            PG8_LDA(At, 0, 1); PG8_STAGE(PG8_SB(0, 0), b2, voffB); PG8_STAGE(PG8_SB(0, 1), b2 + hstep, voffB); PG8_STAGE(PG8_SA(0, 0), a2, voffA);
            PG8_WAIT_V(8); PG8_WAIT_L(0); PG8_BAR; PG8_MMA(1, 0, At, B0); PG8_MMA(1, 1, At, B1); PG8_BAR; PG8_SCHED;
            PG8_LDB(B0, 1, 0); PG8_LDB(B1, 1, 1); PG8_SCHED; PG8_LDA(At, 1, 0); PG8_STAGE(PG8_SA(0, 1), a2 + hstep, voffA);
            PG8_WAIT_V(8); PG8_WAIT_L(0); PG8_BAR; PG8_MMA(0, 0, At, B0); PG8_MMA(0, 1, At, B1); PG8_BAR; PG8_SCHED;
            PG8_LDA(At, 1, 1); PG8_STAGE(PG8_SB(1, 0), b3, voffB); PG8_STAGE(PG8_SB(1, 1), b3 + hstep, voffB); PG8_STAGE(PG8_SA(1, 0), a3, voffA);
            PG8_WAIT_V(8); PG8_WAIT_L(0); PG8_BAR; PG8_MMA(1, 0, At, B0); PG8_MMA(1, 1, At, B1); PG8_BAR; PG8_SCHED;
        }
        if constexpr (ALIGN_EPI) { if (wr == 0) PG8_BAR; }
        const bool keep = E(acc, cur, wr, wc, fr, fq);
        if (!has_next) break;
        if (!keep) {
#pragma unroll
            for (int a = 0; a < 2; ++a)
#pragma unroll
                for (int b = 0; b < 2; ++b)
#pragma unroll
                    for (int m = 0; m < 4; ++m)
#pragma unroll
                        for (int n = 0; n < 2; ++n) acc[a][b][m][n] = (f32x4){0.f, 0.f, 0.f, 0.f};
        }
        cur = nxt; cA = nA; cB = nB; ++ui;
        if constexpr (ALIGN_EPI) { if (wr == 1) PG8_BAR; }
    }
    PG8_WAIT_V(0);
    if constexpr (!ALIGN_EPI) { if (wr == 0) PG8_BAR; }
    PG8_BAR;
#undef PG8_SA
#undef PG8_SB
#undef PG8_STAGE
#undef PG8_LDA
#undef PG8_LDB
#undef PG8_MMA
#undef PG8_WAIT_V
#undef PG8_WAIT_L
#undef PG8_BAR
#undef PG8_SCHED
}
}

constexpr int NWAVES = 8;
constexpr int N_LAUNCHES = MK_N_LAUNCHES;
constexpr int PER_PHASE = 11;
constexpr int BATCH = 4, SEQ = 8192, D = 1024, NZ = 8192, DFF = 2816, NF1 = 2 * DFF;
constexpr int M = BATCH * SEQ;
constexpr float LN_EPS = 1e-5f, RMS_EPS = 1e-6f, ALPHA = 1.189207115002721f;
constexpr float LOG2E = 1.4426950408889634f;

constexpr size_t MiB = 1u << 20;
constexpr size_t WS_CTL = 0, CTL_ZERO_BYTES = 1 * MiB;
constexpr size_t WS_MODP = 1 * MiB;
constexpr size_t WS_MOD = 2 * MiB;
constexpr size_t WS_WIN = 4 * MiB, WS_WA = 20 * MiB, WS_WB = 22 * MiB, WS_WO = 24 * MiB, WS_WF1 = 26 * MiB, WS_WF2 = 37 * MiB, WS_WSG = 43 * MiB;
constexpr size_t WS_HST = 44 * MiB;
constexpr size_t WS_HDEC = 60 * MiB;
constexpr size_t WS_U = 64 * MiB;
constexpr size_t WS_ZQ = 128 * MiB, WS_ZF = 192 * MiB, WS_ZI = 256 * MiB, WS_ZG = 320 * MiB, WS_ZU = 384 * MiB, WS_ZV = 448 * MiB;
constexpr size_t WS_MIXO = 192 * MiB;
constexpr size_t WS_H1 = 320 * MiB;
constexpr size_t WS_HG = 448 * MiB;
constexpr size_t WS_MIX = 128 * MiB;
constexpr size_t WS_ACT = 128 * MiB;
constexpr size_t WS_END = 512 * MiB;
constexpr int CW_TMO = 0, CW_CODE = 1, CW_BAR = 4096;

constexpr int RING_OFF = 0, RING_BYTES = 131072;
constexpr int LDS_BYTES = 163840;
constexpr int LDSCTL_OFF = LDS_BYTES - 1024, MISC_OFF = LDSCTL_OFF + 320;

#define GAS __attribute__((address_space(1)))
#define LAS __attribute__((address_space(3)))
typedef unsigned short bf16;
typedef unsigned v4u __attribute__((ext_vector_type(4)));
typedef unsigned v2u __attribute__((ext_vector_type(2)));
typedef float f32x4 __attribute__((ext_vector_type(4)));
typedef float f32x2 __attribute__((ext_vector_type(2)));
typedef short bf16x8 __attribute__((ext_vector_type(8)));
typedef short bf16x4 __attribute__((ext_vector_type(4)));
typedef GAS unsigned gu32;
#define RLX_AGENT __ATOMIC_RELAXED, __HIP_MEMORY_SCOPE_AGENT
#define LDS_WAIT() asm volatile("s_waitcnt lgkmcnt(0)" ::: "memory")
#define VM_WAIT() asm volatile("s_waitcnt vmcnt(0)" ::: "memory")

__device__ __forceinline__ float bflo(unsigned w) { return __builtin_bit_cast(float, w << 16); }
__device__ __forceinline__ float bfhi(unsigned w) { return __builtin_bit_cast(float, w & 0xffff0000u); }
typedef __bf16 bf16x2_t __attribute__((ext_vector_type(2)));
__device__ __forceinline__ unsigned pk2(float lo, float hi) { f32x2 v = {lo, hi}; bf16x2_t b = __builtin_convertvector(v, bf16x2_t); return __builtin_bit_cast(unsigned, b); }
__device__ __forceinline__ size_t ztile_off(int row, int head) {
    const int G = row >> 10, slot = ((((row >> 6) & 15) << 3) | head) ^ ((G << 2) & 127);
    return ((size_t)((G << 7) | slot) * 64 + (row & 63)) * 128;
}
__device__ __forceinline__ float ex2(float x) { return __builtin_amdgcn_exp2f(x); }
__device__ __forceinline__ float lg2(float x) { return __builtin_amdgcn_logf(x); }
__device__ __forceinline__ float rcpf_(float x) { return __builtin_amdgcn_rcpf(x); }
__device__ __forceinline__ float sigmoidf_(float x) { return rcpf_(1.f + ex2(-x * LOG2E)); }
__device__ __forceinline__ float siluf_(float x) { return x * sigmoidf_(x); }
__device__ __forceinline__ float geluf_(float v) {
    const float av = __builtin_fabsf(v), t = rcpf_(av * 0.2316418882f + 1.0f);
    float q = t * 0.5307027145f + (-0.7265760135f); q = q * t + 0.7107068705f; q = q * t + (-0.142248368f); q = q * t + 0.127414796f; q = q * t;
    const float e = ex2((v * v) * (-0.72134752044f));
    const float m = v * (q * e);
    return v < 0.f ? m : v - m;
}
__device__ __forceinline__ f32x2 gelu_pk(f32x2 v) {
    const f32x2 av = __builtin_elementwise_abs(v), d = av * 0.2316418882f + 1.0f;
    f32x2 t; t.x = rcpf_(d.x); t.y = rcpf_(d.y);
    f32x2 q = t * 0.5307027145f + (-0.7265760135f); q = q * t + 0.7107068705f; q = q * t + (-0.142248368f); q = q * t + 0.127414796f; q = q * t;
    const f32x2 sq = (v * v) * (-0.72134752044f);
    f32x2 e; e.x = ex2(sq.x); e.y = ex2(sq.y);
    const f32x2 m = v * (q * e), r = v - m;
    f32x2 o; o.x = v.x < 0.f ? m.x : r.x; o.y = v.y < 0.f ? m.y : r.y; return o;
}
__device__ __forceinline__ float wave_sum(float v) {
#pragma unroll
    for (int o = 1; o < 64; o <<= 1) v += __shfl_xor(v, o);
    return v;
}

#define XB_TMO      128
#define XB_XCNT(j)  (256  + 64 * (j))
#define XB_XSUB(j)  (1280 + 64 * (j))
#define XB_XGEN(j)  (2304 + 64 * (j))
#define XB_TOP      3328
#define XB_TOPGEN   3392
#define XCD_BAR_WORDS 3456
#define XB_SPIN_CAP (1u << 18)
__device__ __forceinline__ unsigned xb_ld(unsigned* p)              { return __hip_atomic_load(p, __ATOMIC_RELAXED, __HIP_MEMORY_SCOPE_AGENT); }
__device__ __forceinline__ unsigned xb_add(unsigned* p, unsigned v) { return __hip_atomic_fetch_add(p, v, __ATOMIC_RELAXED, __HIP_MEMORY_SCOPE_AGENT); }
__device__ __forceinline__ unsigned xb_xcc_id() { return (unsigned)__builtin_amdgcn_s_getreg((3 << 11) | 20) & 0xFu; }
#define XB_SPIN(cond, bar) do { unsigned _sp = 0; while (cond) { __builtin_amdgcn_s_sleep(1); \
    if ((++_sp & 255u) == 0u) { if (xb_ld(&(bar)[XB_TMO])) break; if (_sp > XB_SPIN_CAP) { atomicAdd(&(bar)[XB_TMO], 1u); break; } } } } while (0)
struct XcdBarrier { unsigned* bar; unsigned x; volatile LAS unsigned* st; };
__device__ __forceinline__ XcdBarrier xcd_barrier_post(unsigned* bar, volatile LAS unsigned* st) {
    XcdBarrier b; b.bar = bar; b.x = xb_xcc_id(); b.st = st;
    if (threadIdx.x == 0) (void)xb_add(&bar[XB_XCNT(b.x)], 1u);
    return b;
}
__device__ __forceinline__ void xcd_barrier_complete(unsigned* bar, unsigned x, unsigned& nloc, unsigned& nx) {
    const unsigned G = gridDim.x * gridDim.y * gridDim.z;
    unsigned sum, cnt, mine, sp = 0u;
    for (;;) {
        sum = 0u; cnt = 0u; mine = 0u;
#pragma unroll
        for (unsigned j = 0; j < 16; ++j) { const unsigned c = xb_ld(&bar[XB_XCNT(j)]); sum += c; cnt += (c > 0u) ? 1u : 0u; mine = (j == x) ? c : mine; }
        if (sum == G) break;
        __builtin_amdgcn_s_sleep(1);
        if ((++sp & 255u) == 0u) { if (xb_ld(&bar[XB_TMO])) break; if (sp > XB_SPIN_CAP) { atomicAdd(&bar[XB_TMO], 1u); break; } }
    }
    nloc = mine > 0u ? mine : 1u; nx = cnt > 0u ? cnt : 1u;
}
__device__ __forceinline__ void xcd_barrier(const XcdBarrier& b) {
    asm volatile("s_waitcnt vmcnt(0)" ::: "memory");
    __syncthreads();
    if (threadIdx.x == 0) {
        unsigned* bar = b.bar;
        __builtin_amdgcn_s_waitcnt(0);
        unsigned nloc = b.st[0], nx = b.st[1];
        if (nloc == 0u) { xcd_barrier_complete(bar, b.x, nloc, nx); b.st[0] = nloc; b.st[1] = nx; }
        const unsigned old = xb_add(&bar[XB_XSUB(b.x)], 1u);
        const unsigned gen = old / nloc;
        if (old + 1u == (gen + 1u) * nloc) {
            __builtin_amdgcn_fence(__ATOMIC_RELEASE, "agent");
            asm volatile("s_waitcnt vmcnt(0)" ::: "memory");
            const unsigned og = xb_add(&bar[XB_TOP], 1u);
            const unsigned tg = og / nx;
            if (og + 1u == (tg + 1u) * nx) xb_add(&bar[XB_TOPGEN], 1u);
            else XB_SPIN(xb_ld(&bar[XB_TOPGEN]) == tg, bar);
            __builtin_amdgcn_fence(__ATOMIC_ACQUIRE, "agent");
            xb_add(&bar[XB_XGEN(b.x)], 1u);
            asm volatile("s_waitcnt vmcnt(0)" ::: "memory");
        } else {
            XB_SPIN(xb_ld(&bar[XB_XGEN(b.x)]) == gen, bar);
            __builtin_amdgcn_fence(__ATOMIC_ACQUIRE, "agent");
            asm volatile("s_waitcnt vmcnt(0)" ::: "memory");
        }
    }
    __syncthreads();
}

struct Frame {
    LAS unsigned char* lds;
    volatile LAS unsigned* MISC;
    gu32* ctl;
    int tid, lane, wave;
    int vcu, G;
    const float* in[21]; float* out; unsigned char* ws;
    unsigned long long tacc, tlast;
};
#define TSEG(k) do { if (MK_TACC >= 0 && blockIdx.x == 0 && F.tid == 0) { const unsigned long long t_ = __builtin_amdgcn_s_memrealtime(); if (MK_TACC == (k)) F.tacc += t_ - F.tlast; F.tlast = t_; } } while (0)
enum { I_X = 0, I_C, I_WADA, I_BADA, I_WIN, I_BGATE, I_LBL, I_HNW, I_WPA, I_GLNW, I_GLNB, I_GWS, I_GBS, I_WPB, I_WOUT, I_LN1W, I_LN1B, I_WF1, I_WF2, I_LN2W, I_LN2B };

__device__ __forceinline__ void p0_transpose_item(const float* W, int K, int N, bf16* WT, int dst_row0, LAS float* scr, int k0, int n0, int lane) {
#pragma unroll 8
    for (int i = 0; i < 32; ++i) { const int kk = 2 * i + (lane >> 5); scr[kk * 33 + (lane & 31)] = W[(size_t)(k0 + kk) * N + n0 + (lane & 31)]; }
    LDS_WAIT(); asm volatile("" ::: "memory");
    const int c = lane & 7;
#pragma unroll
    for (int j = 0; j < 4; ++j) { const int n = (lane >> 3) + 8 * j; const LAS float* s = scr + (8 * c) * 33 + n;
        v4u o; o.x = pk2(s[0 * 33], s[1 * 33]); o.y = pk2(s[2 * 33], s[3 * 33]); o.z = pk2(s[4 * 33], s[5 * 33]); o.w = pk2(s[6 * 33], s[7 * 33]);
        *(GAS v4u*)(WT + (size_t)(dst_row0 + n) * K + k0 + 8 * c) = o; }
    LDS_WAIT(); asm volatile("" ::: "memory");
}
__device__ __forceinline__ void p0_prologue(Frame& F) {
    LAS float* scr = (LAS float*)(F.lds + RING_OFF + F.wave * 16384);
    const int gw = F.vcu * NWAVES + F.wave, NGW = F.G * NWAVES, lane = F.lane;
    constexpr int I_IN = 16 * 256, I_SQ = 16 * 32, I_F1 = 16 * 176, I_F2 = 44 * 32, I_MOD = 768, I_WS = 128;
    constexpr int NITEMS = I_MOD + I_IN + 3 * I_SQ + I_F1 + I_F2 + I_WS;
    for (int it = gw; it < NITEMS; it += NGW) {
        int r = it;
        if (r < I_MOD) {
            const int cg = r % 96, ks = r / 96, col = 64 * cg + lane;
#pragma unroll
            for (int q = 0; q < 8; ++q) { const int idx = q * 64 + lane, b = idx >> 7, kk = idx & 127; scr[idx] = siluf_(F.in[I_C][b * D + ks * 128 + kk]); }
            LDS_WAIT(); asm volatile("" ::: "memory");
            float a0 = 0.f, a1 = 0.f, a2 = 0.f, a3 = 0.f;
            const float* w = F.in[I_WADA] + (size_t)(ks * 128) * 6144 + col;
#pragma unroll 8
            for (int kk = 0; kk < 128; ++kk) { const float wv = w[(size_t)kk * 6144]; a0 += scr[kk] * wv; a1 += scr[128 + kk] * wv; a2 += scr[256 + kk] * wv; a3 += scr[384 + kk] * wv; }
            float* mp = (float*)(F.ws + WS_MODP) + (size_t)(ks * 4) * 6144 + col;
            mp[0] = a0; mp[6144] = a1; mp[2 * 6144] = a2; mp[3 * 6144] = a3;
            LDS_WAIT(); asm volatile("" ::: "memory");
            continue;
        }
        r -= I_MOD;
        if (r < I_IN) { p0_transpose_item(F.in[I_WIN], D, NZ, (bf16*)(F.ws + WS_WIN), 32 * (r % 256), scr, 64 * (r / 256), 32 * (r % 256), lane); continue; } r -= I_IN;
        if (r < I_SQ) { p0_transpose_item(F.in[I_WPA], D, D, (bf16*)(F.ws + WS_WA), 32 * (r % 32), scr, 64 * (r / 32), 32 * (r % 32), lane); continue; } r -= I_SQ;
        if (r < I_SQ) { p0_transpose_item(F.in[I_WPB], D, D, (bf16*)(F.ws + WS_WB), 32 * (r % 32), scr, 64 * (r / 32), 32 * (r % 32), lane); continue; } r -= I_SQ;
        if (r < I_SQ) { p0_transpose_item(F.in[I_WOUT], D, D, (bf16*)(F.ws + WS_WO), 32 * (r % 32), scr, 64 * (r / 32), 32 * (r % 32), lane); continue; } r -= I_SQ;
        if (r < I_F1) {
            const int n0 = 32 * (r % 176), k0 = 64 * (r / 176);
            const int n1 = n0 < DFF ? n0 : n0 - DFF; const int dst = (n1 / 128) * 256 + (n0 < DFF ? 0 : 128) + (n1 % 128);
            p0_transpose_item(F.in[I_WF1], D, NF1, (bf16*)(F.ws + WS_WF1), dst, scr, k0, n0, lane); continue; } r -= I_F1;
        if (r < I_F2) { p0_transpose_item(F.in[I_WF2], DFF, D, (bf16*)(F.ws + WS_WF2), 32 * (r % 32), scr, 64 * (r / 32), 32 * (r % 32), lane); continue; } r -= I_F2;
        {
            const int e0 = r * 1024 + lane * 16; const float* src = F.in[I_GWS] + e0; unsigned o[8];
#pragma unroll
            for (int q = 0; q < 8; ++q) { const int e = e0 + 2 * q, s = e & 127, t = (e >> 7) & 127; const bool z = (t < 64) && (s >= 64); o[q] = z ? 0u : pk2(src[2 * q], src[2 * q + 1]); }
            GAS v4u* dst = (GAS v4u*)((bf16*)(F.ws + WS_WSG) + e0);
            dst[0] = (v4u){o[0], o[1], o[2], o[3]}; dst[1] = (v4u){o[4], o[5], o[6], o[7]};
        }
    }
}

__device__ __forceinline__ float mod_value(Frame& F, int b, int col) {
    const float* mp = (const float*)(F.ws + WS_MODP) + (size_t)b * 6144 + col; float s = F.in[I_BADA][col];
#pragma unroll
    for (int ks = 0; ks < 8; ++ks) s += mp[(size_t)ks * 4 * 6144];
    return s;
}
__device__ __forceinline__ void p1_adaln_in(Frame& F) {
    LAS float* tab = (LAS float*)(F.lds + RING_OFF);
    for (int wg = blockIdx.x; wg < M / 128; wg += F.G) {
        const int b = wg / (SEQ / 128);
        __syncthreads();
        for (int idx = F.tid; idx < 2048; idx += NWAVES * 64) { const float v = mod_value(F, b, idx); tab[idx] = idx < 1024 ? v : 1.f + v; }
        if (F.tid < 96) { const int bb = F.tid / 24, col = 24 * wg + F.tid % 24; ((float*)(F.ws + WS_MOD))[bb * 6144 + col] = mod_value(F, bb, col); }
        __syncthreads();
        const size_t rowb = (size_t)wg * 128 + F.wave * 16;
        const GAS f32x4* xb = (const GAS f32x4*)(F.in[I_X] + rowb * D) + F.lane;
        f32x4 nx[4];
#pragma unroll
        for (int j = 0; j < 4; ++j) nx[j] = xb[64 * j];
        for (int i = 0; i < 16; ++i) {
            f32x4 v[4]; float s = 0.f;
#pragma unroll
            for (int j = 0; j < 4; ++j) { v[j] = nx[j]; s += (v[j].x + v[j].y) + (v[j].z + v[j].w); }
            if (i + 1 < 16) {
#pragma unroll
                for (int j = 0; j < 4; ++j) nx[j] = xb[(size_t)(i + 1) * 256 + 64 * j];
            }
            const float mean = wave_sum(s) * (1.f / D); float s2 = 0.f;
#pragma unroll
            for (int j = 0; j < 4; ++j) { v[j] = v[j] - mean; s2 += (v[j].x * v[j].x + v[j].y * v[j].y) + (v[j].z * v[j].z + v[j].w * v[j].w); }
            const float rstd = __builtin_amdgcn_rsqf(wave_sum(s2) * (1.f / D) + LN_EPS);
            GAS v2u* o8 = (GAS v2u*)((bf16*)(F.ws + WS_U) + (rowb + i) * D) + F.lane;
#pragma unroll
            for (int j = 0; j < 4; ++j) { const f32x4 sh = *(const LAS f32x4*)(tab + 4 * F.lane + 256 * j), sc = *(const LAS f32x4*)(tab + 1024 + 4 * F.lane + 256 * j);
                const f32x4 y = v[j] * rstd * sc + sh; o8[64 * j] = (v2u){pk2(y.x, y.y), pk2(y.z, y.w)}; }
        }
    }
}

struct EpiZ {
    static constexpr bool PERM = true;
    bf16* z0; bf16* zg; const float* bgate;
    __device__ __forceinline__ bool operator()(f32x4 (&acc)[2][2][4][2], const pg8::Unit& u, int wr, int wc, int fr, int fq) const {
        const int t = u.pn >> 2; bf16* base = t < 6 ? z0 + (size_t)t * M * D : zg + (size_t)(t - 6) * M * D;
        const int row0 = u.pm * 256 + wr * 64 + fr, col0 = (u.pn & 3) * 256 + wc * 32 + 8 * fq;
        if (t >= 6) {
#pragma unroll
            for (int bj = 0; bj < 2; ++bj) { float bg[8];
#pragma unroll
                for (int q = 0; q < 8; ++q) bg[q] = bgate[(t - 6) * D + col0 + bj * 128 + q];
#pragma unroll
                for (int ai = 0; ai < 2; ++ai)
#pragma unroll
                    for (int m = 0; m < 4; ++m) { float o[8];
#pragma unroll
                        for (int q = 0; q < 8; ++q) o[q] = sigmoidf_(acc[ai][bj][m][q >> 2][q & 3] + bg[q]);
                        *(v4u*)(base + (size_t)(row0 + ai * 128 + m * 16) * D + col0 + bj * 128) = (v4u){pk2(o[0], o[1]), pk2(o[2], o[3]), pk2(o[4], o[5]), pk2(o[6], o[7])}; } }
            return false;
        }
#pragma unroll
        for (int ai = 0; ai < 2; ++ai)
#pragma unroll
            for (int m = 0; m < 4; ++m) { const int row = row0 + ai * 128 + m * 16;
#pragma unroll
                for (int bj = 0; bj < 2; ++bj) { const f32x4 v0 = acc[ai][bj][m][0], v1 = acc[ai][bj][m][1]; const int col = col0 + bj * 128;
                    bf16* p = t < 4 ? base + ztile_off(row, col >> 7) + (col & 127) : base + (size_t)row * D + col;
                    *(v4u*)p = (v4u){pk2(v0[0], v0[1]), pk2(v0[2], v0[3]), pk2(v1[0], v1[1]), pk2(v1[2], v1[3])}; } }
        return false;
    }
};
struct EpiProj {
    static constexpr bool PERM = true;
    const bf16* ga; const bf16* gb; bf16* mix;
    __device__ __forceinline__ bool operator()(f32x4 (&acc)[2][2][4][2], const pg8::Unit& u, int wr, int wc, int fr, int fq) const {
        const int row0 = u.pm * 256 + wr * 64 + fr, col0 = u.pn * 256 + wc * 32 + 8 * fq;
#pragma unroll
        for (int ai = 0; ai < 2; ++ai)
#pragma unroll
            for (int m = 0; m < 4; ++m)
#pragma unroll
                for (int bj = 0; bj < 2; ++bj) {
                    const size_t off = (size_t)(row0 + ai * 128 + m * 16) * D + col0 + bj * 128;
                    const v4u zb = *(const v4u*)(gb + off);
                    if (u.kind == 0) {
                        const v4u za = *(const v4u*)(ga + off);
#pragma unroll
                        for (int q = 0; q < 4; ++q) { acc[ai][bj][m][q >> 1][2 * (q & 1)] *= bflo(za[q]) * rcpf_(bflo(zb[q])); acc[ai][bj][m][q >> 1][2 * (q & 1) + 1] *= bfhi(za[q]) * rcpf_(bfhi(zb[q])); }
                    } else {
                        float o[8];
#pragma unroll
                        for (int q = 0; q < 4; ++q) { o[2 * q] = acc[ai][bj][m][q >> 1][2 * (q & 1)] * bflo(zb[q]); o[2 * q + 1] = acc[ai][bj][m][q >> 1][2 * (q & 1) + 1] * bfhi(zb[q]); }
                        *(v4u*)(mix + off) = (v4u){pk2(o[0], o[1]), pk2(o[2], o[3]), pk2(o[4], o[5]), pk2(o[6], o[7])};
                    }
                }
        return u.kind == 0;
    }
};
struct EpiBf {
    static constexpr bool PERM = true;
    bf16* o;
    __device__ __forceinline__ bool operator()(f32x4 (&acc)[2][2][4][2], const pg8::Unit& u, int wr, int wc, int fr, int fq) const {
        const int row0 = u.pm * 256 + wr * 64 + fr, col0 = u.pn * 256 + wc * 32 + 8 * fq;
#pragma unroll
        for (int ai = 0; ai < 2; ++ai)
#pragma unroll
            for (int m = 0; m < 4; ++m)
#pragma unroll
                for (int bj = 0; bj < 2; ++bj) { const f32x4 v0 = acc[ai][bj][m][0], v1 = acc[ai][bj][m][1];
                    *(v4u*)(o + (size_t)(row0 + ai * 128 + m * 16) * D + col0 + bj * 128) = (v4u){pk2(v0[0], v0[1]), pk2(v0[2], v0[3]), pk2(v1[0], v1[1]), pk2(v1[2], v1[3])}; }
        return false;
    }
};
struct EpiRes {
    static constexpr bool PERM = false;
    const float* base; const float* gate  ; float* out;
    __device__ __forceinline__ bool operator()(f32x4 (&acc)[2][2][4][2], const pg8::Unit& u, int wr, int wc, int fr, int fq) const {
        const int row0 = u.pm * 256 + wr * 64 + fr, col0 = u.pn * 256 + wc * 32 + 4 * fq; const int b = (u.pm * 256) / SEQ;
        f32x4 gv[2][2];
#pragma unroll
        for (int bj = 0; bj < 2; ++bj)
#pragma unroll
            for (int n = 0; n < 2; ++n) gv[bj][n] = *(const f32x4*)(gate + (size_t)b * 6144 + col0 + bj * 128 + n * 16);
        f32x4 bs[2][2][2];
#define EPIRES_LOAD(buf, gi) do { const size_t off_ = (size_t)(row0 + ((gi) >> 2) * 128 + ((gi) & 3) * 16) * D + col0; \
            _Pragma("unroll") for (int bj = 0; bj < 2; ++bj) _Pragma("unroll") for (int n = 0; n < 2; ++n) bs[buf][bj][n] = *(const f32x4*)(base + off_ + bj * 128 + n * 16); } while (0)
        EPIRES_LOAD(0, 0);
#pragma unroll
        for (int gi = 0; gi < 8; ++gi) { const int ai = gi >> 2, m = gi & 3; const size_t off = (size_t)(row0 + ai * 128 + m * 16) * D + col0;
            if (gi + 1 < 8) EPIRES_LOAD((gi + 1) & 1, gi + 1);
#pragma unroll
            for (int bj = 0; bj < 2; ++bj)
#pragma unroll
                for (int n = 0; n < 2; ++n) *(f32x4*)(out + off + bj * 128 + n * 16) = bs[gi & 1][bj][n] * ALPHA + gv[bj][n] * acc[ai][bj][m][n];
        }
#undef EPIRES_LOAD
        return false;
    }
};
struct EpiSwiGLU {
    static constexpr bool PERM = true;
    bf16* act;
    __device__ __forceinline__ bool operator()(f32x4 (&acc)[2][2][4][2], const pg8::Unit& u, int wr, int wc, int fr, int fq) const {
        const int row0 = u.pm * 256 + wr * 64 + fr, col0 = u.pn * 128 + wc * 32 + 8 * fq;
#pragma unroll
        for (int ai = 0; ai < 2; ++ai)
#pragma unroll
            for (int m = 0; m < 4; ++m) { float o[8];
#pragma unroll
                for (int q = 0; q < 8; ++q) { const float a = acc[ai][0][m][q >> 2][q & 3], bb = acc[ai][1][m][q >> 2][q & 3]; o[q] = siluf_(a) * bb; }
                *(v4u*)(act + (size_t)(row0 + ai * 128 + m * 16) * DFF + col0) = (v4u){pk2(o[0], o[1]), pk2(o[2], o[3]), pk2(o[4], o[5]), pk2(o[6], o[7])}; }
        return false;
    }
};

constexpr int HG_K1T = 0, HG_VT1 = 18432, HG_TOT1 = 36864, HG_DEC1 = 40960;
constexpr int HG_Q2 = 0, HG_K2 = 17408, HG_O = 0, HG_K2T = 34816, HG_VT = 53248, HG_SPT = 71680, HG_TOT = 106496, HG_E0 = 110592, HG_E1 = 111104;

typedef short v4i16_t __attribute__((ext_vector_type(4)));
constexpr int TP = 272, TILE_B = 64 * TP;
__device__ __forceinline__ int offb(int row, int ch) { return TP * row + 16 * ch; }
__device__ __forceinline__ int tr_off(int lane, int c, int ks, int t) { const int g = lane >> 4, q = (lane >> 2) & 3, p = lane & 3; return offb(32 * ks + 8 * g + 4 * t + q, 2 * c + (p >> 1)) + 8 * (p & 1); }
#define TR_READ(dst, addr) asm volatile("ds_read_b64_tr_b16 %0, %1" : "=&v"(dst) : "v"(addr) : "memory")
#define TR_WAIT() do { asm volatile("s_waitcnt lgkmcnt(0)" ::: "memory"); __builtin_amdgcn_sched_barrier(0); } while (0)
#define TR_CAT(lo, hi) __builtin_shufflevector(lo, hi, 0, 1, 2, 3, 4, 5, 6, 7)
__device__ __forceinline__ unsigned lds_addr(const LAS unsigned char* p) { return (unsigned)(__SIZE_TYPE__)p; }
__device__ __forceinline__ void tile_load(const unsigned char* gtile, int tid, v4u (&r)[2]) { const GAS v4u* p = (const GAS v4u*)gtile + tid; r[0] = p[0]; r[1] = p[512]; }
__device__ __forceinline__ void tile_to_lds(LAS unsigned char* img, int tid, const v4u (&r)[2]) {
#pragma unroll
    for (int q = 0; q < 2; ++q) { const int id = tid + 512 * q; *(LAS v4u*)(img + offb(id >> 4, id & 15)) = r[q]; }
}
constexpr int H1_RAW = 0, H1_K1 = 4 * TILE_B, H1_TOT = 5 * TILE_B, H1_DEC = H1_TOT + 4096;
template <int VARIANT> __device__ __forceinline__ void hgrn_local_states(Frame& F) {
    LAS unsigned char* L = F.lds + RING_OFF;
    const int lane = F.lane, w = F.wave, g = lane >> 4, tid = F.tid;
    for (int item = blockIdx.x; item < 256; item += F.G) {
        const int bh = item >> 3, j = item & 7, b = bh >> 3, h = bh & 7;
        const int row0 = b * SEQ + j * 1024;
        const int col = h * 128 + 2 * lane;
        const float* lbl = F.in[I_LBL];
        const float lb0 = rcpf_(1.f + ex2((lbl[1024 + col] - lbl[col]) * LOG2E)), lb1 = rcpf_(1.f + ex2((lbl[1024 + col + 1] - lbl[col + 1]) * LOG2E));
#define GZF(n) (F.ws + WS_ZF + ztile_off(row0 + 64 * (n), h) * 2)
#define GZI(n) (F.ws + WS_ZI + ztile_off(row0 + 64 * (n), h) * 2)
        f32x4 acc[8];
#pragma unroll
        for (int vb = 0; vb < 8; ++vb) acc[vb] = (f32x4){0.f, 0.f, 0.f, 0.f};
        float ds0 = 0.f, ds1 = 0.f;
        v4u tf[2], ti[2];
        __syncthreads();
        tile_load(GZF(0), tid, tf); tile_load(GZI(0), tid, ti);
        tile_to_lds(L + H1_RAW, tid, tf); tile_to_lds(L + H1_RAW + TILE_B, tid, ti);
        tile_load(GZF(1), tid, tf); tile_load(GZI(1), tid, ti);
        __syncthreads();
        for (int n = 0; n < 16; ++n) {
            LAS unsigned char* const raw = L + H1_RAW + (n & 1) * 2 * TILE_B;
            float f0[8], f1[8], c0[8], c1[8]; float r0 = 0.f, r1 = 0.f;
#pragma unroll
            for (int i = 0; i < 8; ++i) {
                const unsigned x = *(const LAS unsigned*)(raw + offb(8 * w + i, lane >> 2) + 4 * (lane & 3));
                f0[i] = lb0 + (1.f - lb0) * sigmoidf_(bflo(x)); f1[i] = lb1 + (1.f - lb1) * sigmoidf_(bfhi(x));
                r0 += lg2(f0[i]); r1 += lg2(f1[i]); c0[i] = r0; c1[i] = r1; }
            *(LAS f32x2*)(L + H1_TOT + (w * 128 + 2 * lane) * 4) = (f32x2){r0, r1};
            __syncthreads();
            float p0 = 0.f, p1 = 0.f, a0 = 0.f, a1 = 0.f;
#pragma unroll
            for (int o = 0; o < 8; ++o) { const f32x2 t = *(const LAS f32x2*)(L + H1_TOT + (o * 128 + 2 * lane) * 4); a0 += t.x; a1 += t.y; if (o < w) { p0 += t.x; p1 += t.y; } }
#pragma unroll
            for (int i = 0; i < 8; ++i) { const float k0 = (1.f - f0[i]) * ex2(a0 - p0 - c0[i]), k1 = (1.f - f1[i]) * ex2(a1 - p1 - c1[i]);
                *(LAS unsigned*)(L + H1_K1 + offb(8 * w + i, lane >> 2) + 4 * (lane & 3)) = pk2(k0, k1); }
            if (w == 0) *(LAS f32x2*)(L + H1_DEC + (2 * lane) * 4) = (f32x2){ex2(a0), ex2(a1)};
            ds0 += a0; ds1 += a1;
            if (n + 1 < 16) { LAS unsigned char* const nraw = L + H1_RAW + ((n + 1) & 1) * 2 * TILE_B; tile_to_lds(nraw, tid, tf); tile_to_lds(nraw + TILE_B, tid, ti); }
            if (n + 2 < 16) { tile_load(GZF(n + 2), tid, tf); tile_load(GZI(n + 2), tid, ti); }
            __syncthreads();
            const f32x4 dec = *(const LAS f32x4*)(L + H1_DEC + (16 * w + 4 * g) * 4);
#pragma unroll
            for (int vb = 0; vb < 8; ++vb) acc[vb] = acc[vb] * dec;
#pragma unroll
            for (int ks = 0; ks < 2; ++ks) {
                bf16x4 alo, ahi, blo[8], bhi[8];
                TR_READ(alo, lds_addr(L + H1_K1) + tr_off(lane, w, ks, 0)); TR_READ(ahi, lds_addr(L + H1_K1) + tr_off(lane, w, ks, 1));
#pragma unroll
                for (int vb = 0; vb < 8; ++vb) { TR_READ(blo[vb], lds_addr(raw + TILE_B) + tr_off(lane, vb, ks, 0)); TR_READ(bhi[vb], lds_addr(raw + TILE_B) + tr_off(lane, vb, ks, 1)); }
                TR_WAIT();
                const bf16x8 a = TR_CAT(alo, ahi);
#pragma unroll
                for (int vb = 0; vb < 8; ++vb) acc[vb] = __builtin_amdgcn_mfma_f32_16x16x32_bf16(a, TR_CAT(blo[vb], bhi[vb]), acc[vb], 0, 0, 0);
            }
        }
        GAS f32x4* hst = (GAS f32x4*)(F.ws + (VARIANT ? WS_U : WS_HST)) + ((size_t)(item * 8 + w) * 8) * 64 + lane;
#pragma unroll
        for (int vb = 0; vb < 8; ++vb) hst[vb * 64] = acc[vb];
        if (w == 0) *(GAS f32x2*)((float*)(F.ws + (VARIANT ? WS_U + 32 * MiB : WS_HDEC)) + item * 128 + 2 * lane) = (f32x2){ds0, ds1};
        __syncthreads();
    }
}

constexpr size_t WS_SINIT = WS_U;
__device__ __forceinline__ void hgrn_scan_states(Frame& F) {
    const int tid = F.tid, lane = tid & 63, vb = tid >> 6;
    for (int item = blockIdx.x; item < 256; item += F.G) {
        const int bh = item >> 3, w = item & 7;
        f32x4 x[7], dl[7];
#pragma unroll
        for (int i = 0; i < 7; ++i) { x[i] = *((const GAS f32x4*)(F.ws + WS_HST) + ((size_t)((bh * 8 + i) * 8 + w) * 8 + vb) * 64 + lane); dl[i] = *(const GAS f32x4*)((const float*)(F.ws + WS_HDEC) + (bh * 8 + i) * 128 + 16 * w + 4 * (lane >> 4)); }
        f32x4 S = (f32x4){0.f, 0.f, 0.f, 0.f};
#pragma unroll
        for (int i = 0; i < 7; ++i) { const f32x4 d = (f32x4){ex2(dl[i].x), ex2(dl[i].y), ex2(dl[i].z), ex2(dl[i].w)}; S = S * d + x[i];
            *((GAS f32x4*)(F.ws + WS_SINIT) + ((size_t)((bh * 8 + i + 1) * 8 + w) * 8 + vb) * 64 + lane) = S; }
    }
}
constexpr int H3_RQ = 0, H3_RF = TILE_B, H3_RI = 2 * TILE_B, H3_Q2 = 4 * TILE_B, H3_K2 = 5 * TILE_B, H3_SPT = 6 * TILE_B, H3_O = 8 * TILE_B, H3_TOT = 9 * TILE_B, H3_E0 = H3_TOT + 4096, H3_E1 = H3_E0 + 512, H3_END = H3_E1 + 512;
static_assert(H3_END <= LDSCTL_OFF, "M3 LDS map");
__device__ __forceinline__ int tr_off2(int lane, int c, int rowg) { const int q = (lane >> 2) & 3, p = lane & 3; return offb(rowg + q, 2 * c + (p >> 1)) + 8 * (p & 1); }
__device__ __forceinline__ void hgrn_outputs(Frame& F) {
    LAS unsigned char* L = F.lds + RING_OFF;
    const int lane = F.lane, w = F.wave, tb = w >> 1, tid = F.tid;
    for (int item = blockIdx.x; item < 256; item += F.G) {
        TSEG(-2);
        const int bh = item >> 3, j = item & 7, b = bh >> 3, h = bh & 7;
        const int row0 = b * SEQ + j * 1024;
        const int col = h * 128 + 2 * lane;
        const float* lbl = F.in[I_LBL];
        const float lb0 = rcpf_(1.f + ex2((lbl[1024 + col] - lbl[col]) * LOG2E)), lb1 = rcpf_(1.f + ex2((lbl[1024 + col + 1] - lbl[col + 1]) * LOG2E));
#define GZT(A, n) (F.ws + (A) + ztile_off(row0 + 64 * (n), h) * 2)
        const int och = tid & 15, orow = tid >> 4;
        f32x4 nwa = *(const GAS f32x4*)(F.in[I_HNW] + 8 * och), nwb = *(const GAS f32x4*)(F.in[I_HNW] + 8 * och + 4);
        bf16* hgp = (bf16*)(F.ws + WS_HG) + (size_t)(row0 + orow) * D + h * 128 + 8 * och;
        f32x4 S[8];
#pragma unroll
        for (int vb = 0; vb < 8; ++vb) S[vb] = j ? *((const GAS f32x4*)(F.ws + WS_SINIT) + ((size_t)(item * 8 + w) * 8 + vb) * 64 + lane) : (f32x4){0.f, 0.f, 0.f, 0.f};
        v4u tq[2], tf[2], ti[2], tg[2];
        __syncthreads();
        tile_load(GZT(WS_ZQ, 0), tid, tq); tile_load(GZT(WS_ZF, 0), tid, tf); tile_load(GZT(WS_ZI, 0), tid, ti);
        tile_to_lds(L + H3_RQ, tid, tq); tile_to_lds(L + H3_RF, tid, tf); tile_to_lds(L + H3_RI, tid, ti);
        tile_load(GZT(WS_ZQ, 1), tid, tq); tile_load(GZT(WS_ZF, 1), tid, tf); tile_load(GZT(WS_ZI, 1), tid, ti);
        __syncthreads();
        TSEG(0);
        for (int n = 0; n < 16; ++n) {
            LAS unsigned char* const rawi = L + H3_RI + (n & 1) * TILE_B;
            const int lv = lane, fr = lv & 15, g = lv >> 4;
            tile_load(GZT(WS_ZG, n), tid, tg);
            float f0[8], f1[8], c0[8], c1[8], q0[8], q1[8]; float r0 = 0.f, r1 = 0.f;
#pragma unroll
            for (int i = 0; i < 8; ++i) {
                const int ro = offb(8 * w + i, lv >> 2) + 4 * (lv & 3);
                const unsigned xf = *(const LAS unsigned*)(L + H3_RF + ro), xq = *(const LAS unsigned*)(L + H3_RQ + ro);
                f0[i] = lb0 + (1.f - lb0) * sigmoidf_(bflo(xf)); f1[i] = lb1 + (1.f - lb1) * sigmoidf_(bfhi(xf));
                r0 += lg2(f0[i]); r1 += lg2(f1[i]); c0[i] = r0; c1[i] = r1;
                q0[i] = siluf_(bflo(xq)); q1[i] = siluf_(bfhi(xq));
            }
            *(LAS f32x2*)(L + H3_TOT + (w * 128 + 2 * lv) * 4) = (f32x2){r0, r1};
            __syncthreads();
            TSEG(1);
            float p0 = 0.f, p1 = 0.f, a0 = 0.f, a1 = 0.f, m0 = 0.f, m1 = 0.f;
#pragma unroll
            for (int o = 0; o < 8; ++o) { const f32x2 t = *(const LAS f32x2*)(L + H3_TOT + (o * 128 + 2 * lv) * 4); a0 += t.x; a1 += t.y; if (o < w) { p0 += t.x; p1 += t.y; } if (o < 4) { m0 += t.x; m1 += t.y; } }
#pragma unroll
            for (int i = 0; i < 8; ++i) {
                const int ro = offb(8 * w + i, lv >> 2) + 4 * (lv & 3);
                const float d0 = p0 + c0[i] - m0, d1 = p1 + c1[i] - m1;
                *(LAS unsigned*)(L + H3_Q2 + ro) = pk2(q0[i] * ex2(d0), q1[i] * ex2(d1));
                *(LAS unsigned*)(L + H3_K2 + ro) = pk2((1.f - f0[i]) * ex2(-d0), (1.f - f1[i]) * ex2(-d1));
            }
            if (w == 0) { *(LAS f32x2*)(L + H3_E0 + (2 * lv) * 4) = (f32x2){ex2(m0), ex2(m1)}; *(LAS f32x2*)(L + H3_E1 + (2 * lv) * 4) = (f32x2){ex2(a0 - m0), ex2(a1 - m1)}; }
            __syncthreads();
            TSEG(2);
            const f32x4 e0 = *(const LAS f32x4*)(L + H3_E0 + (16 * w + 4 * g) * 4), e1 = *(const LAS f32x4*)(L + H3_E1 + (16 * w + 4 * g) * 4);
#pragma unroll
            for (int vb = 0; vb < 8; ++vb) { S[vb] = S[vb] * e0; *(LAS v2u*)(L + H3_SPT + offb(16 * vb + fr, 2 * w + (g >> 1)) + 8 * (g & 1)) = (v2u){pk2(S[vb].x, S[vb].y), pk2(S[vb].z, S[vb].w)}; }
            bf16x8 qf[4];
#pragma unroll
            for (int kk = 0; kk < 4; ++kk) qf[kk] = *(const LAS bf16x8*)(L + H3_Q2 + offb(16 * tb + fr, 4 * kk + g));
            f32x4 st[4];
#pragma unroll
            for (int sb = 0; sb < 4; ++sb) { st[sb] = (f32x4){0.f, 0.f, 0.f, 0.f};
                if (sb <= tb) {
#pragma unroll
                    for (int kk = 0; kk < 4; ++kk) { const bf16x8 a = *(const LAS bf16x8*)(L + H3_K2 + offb(16 * sb + fr, 4 * kk + g));
                        st[sb] = __builtin_amdgcn_mfma_f32_16x16x32_bf16(a, qf[kk], st[sb], 0, 0, 0); }
                    if (sb == tb) {
#pragma unroll
                        for (int r = 0; r < 4; ++r) st[sb][r] = (4 * g + r <= fr) ? st[sb][r] : 0.f;
                    }
                } }
            bf16x8 pf[2];
#pragma unroll
            for (int ks = 0; ks < 2; ++ks) { const v4u pw = (v4u){pk2(st[2 * ks].x, st[2 * ks].y), pk2(st[2 * ks].z, st[2 * ks].w), pk2(st[2 * ks + 1].x, st[2 * ks + 1].y), pk2(st[2 * ks + 1].z, st[2 * ks + 1].w)}; pf[ks] = __builtin_bit_cast(bf16x8, pw); }
#pragma unroll
            for (int ks = 0; ks < 2; ++ks) {
                bf16x4 alo, ahi, blo[8], bhi[8];
                TR_READ(alo, lds_addr(L + H3_K2) + tr_off(lv, w, ks, 0)); TR_READ(ahi, lds_addr(L + H3_K2) + tr_off(lv, w, ks, 1));
#pragma unroll
                for (int vb = 0; vb < 8; ++vb) { TR_READ(blo[vb], lds_addr(rawi) + tr_off(lv, vb, ks, 0)); TR_READ(bhi[vb], lds_addr(rawi) + tr_off(lv, vb, ks, 1)); }
                TR_WAIT();
                const bf16x8 a = TR_CAT(alo, ahi);
#pragma unroll
                for (int vb = 0; vb < 8; ++vb) S[vb] = __builtin_amdgcn_mfma_f32_16x16x32_bf16(a, TR_CAT(blo[vb], bhi[vb]), S[vb], 0, 0, 0);
            }
#pragma unroll
            for (int vb = 0; vb < 8; ++vb) S[vb] = S[vb] * e1;
            __syncthreads();
            TSEG(3);
            f32x4 oa[4];
            {
                bf16x4 vlo[2][4], vhi[2][4];
#pragma unroll
                for (int ks = 0; ks < 2; ++ks) if (2 * ks <= tb) {
#pragma unroll
                    for (int v4 = 0; v4 < 4; ++v4) { const int vb = 4 * (w & 1) + v4;
                        TR_READ(vlo[ks][v4], lds_addr(rawi) + tr_off2(lv, vb, 32 * ks + 4 * g)); TR_READ(vhi[ks][v4], lds_addr(rawi) + tr_off2(lv, vb, 32 * ks + 16 + 4 * g)); } }
                bf16x8 qf2[4];
#pragma unroll
                for (int kk = 0; kk < 4; ++kk) qf2[kk] = *(const LAS bf16x8*)(L + H3_Q2 + offb(16 * tb + fr, 4 * kk + g));
                TR_WAIT();
#pragma unroll
                for (int v4 = 0; v4 < 4; ++v4) { const int vb = 4 * (w & 1) + v4; oa[v4] = (f32x4){0.f, 0.f, 0.f, 0.f};
#pragma unroll
                    for (int ks = 0; ks < 2; ++ks) if (2 * ks <= tb) oa[v4] = __builtin_amdgcn_mfma_f32_16x16x32_bf16(pf[ks], TR_CAT(vlo[ks][v4], vhi[ks][v4]), oa[v4], 0, 0, 0);
#pragma unroll
                    for (int kk = 0; kk < 4; ++kk) { const bf16x8 bv = *(const LAS bf16x8*)(L + H3_SPT + offb(16 * vb + fr, 4 * kk + g));
                        oa[v4] = __builtin_amdgcn_mfma_f32_16x16x32_bf16(qf2[kk], bv, oa[v4], 0, 0, 0); }
                }
            }
#pragma unroll
            for (int v4 = 0; v4 < 4; ++v4) { const int vb = 4 * (w & 1) + v4;
#pragma unroll
                for (int r = 0; r < 4; ++r) *(LAS unsigned short*)(L + H3_O + offb(16 * tb + 4 * g + r, 2 * vb + (fr >> 3)) + 2 * (fr & 7)) = (unsigned short)(pk2(oa[v4][r], 0.f) & 0xffffu); }
            if (n + 1 < 16) { tile_to_lds(L + H3_RQ, tid, tq); tile_to_lds(L + H3_RF, tid, tf); tile_to_lds(L + H3_RI + ((n + 1) & 1) * TILE_B, tid, ti); }
            if (n + 2 < 16) { tile_load(GZT(WS_ZQ, n + 2), tid, tq); tile_load(GZT(WS_ZF, n + 2), tid, tf); tile_load(GZT(WS_ZI, n + 2), tid, ti); }
            __syncthreads();
            TSEG(4);
#pragma unroll
            for (int q = 0; q < 2; ++q) {
                const v4u ov = *(const LAS v4u*)(L + H3_O + offb(orow + 32 * q, och));
                float x[8];
#pragma unroll
                for (int e = 0; e < 4; ++e) { x[2 * e] = bflo(ov[e]); x[2 * e + 1] = bfhi(ov[e]); }
                float ss = 0.f;
#pragma unroll
                for (int e = 0; e < 8; ++e) ss += x[e] * x[e];
                ss += __shfl_xor(ss, 1); ss += __shfl_xor(ss, 2); ss += __shfl_xor(ss, 4); ss += __shfl_xor(ss, 8);
                const float rs = __builtin_amdgcn_rsqf(ss * (1.f / 128.f) + RMS_EPS);
                float y[8];
#pragma unroll
                for (int e = 0; e < 4; ++e) { y[2 * e] = x[2 * e] * rs * (e < 2 ? nwa[2 * e] : nwb[2 * e - 4]) * siluf_(bflo(tg[q][e])); y[2 * e + 1] = x[2 * e + 1] * rs * (e < 2 ? nwa[2 * e + 1] : nwb[2 * e - 3]) * siluf_(bfhi(tg[q][e])); }
                *(v4u*)(hgp + (size_t)(n * 64 + 32 * q) * D) = (v4u){pk2(y[0], y[1]), pk2(y[2], y[3]), pk2(y[4], y[5]), pk2(y[6], y[7])};
            }
            TSEG(5);
        }
        __syncthreads();
    }
}

constexpr int GM_VN = 0, GM_O = 128 * TP, GM_MU = 2 * 128 * TP, GM_RS = GM_MU + 512, GM_LNW = GM_RS + 512, GM_LNB = GM_LNW + 4096;
__device__ __forceinline__ void gmlp_phase(Frame& F) {
    LAS unsigned char* L = F.lds + RING_OFF;
    const int lane = F.lane, w = F.wave, fr = lane & 15, g4 = lane >> 4, tid = F.tid;
    const int och = tid & 15, orow = tid >> 4;
    for (int item = blockIdx.x; item < M / 128; item += F.G) {
        const size_t row0 = (size_t)item * 128;
        __syncthreads();
        TSEG(-3);
        for (int idx = tid; idx < 1024; idx += NWAVES * 64) { *(LAS float*)(L + GM_LNW + idx * 4) = F.in[I_GLNW][idx]; *(LAS float*)(L + GM_LNB + idx * 4) = F.in[I_GLNB][idx]; }
        {
            GAS v4u* p = (GAS v4u*)((bf16*)(F.ws + WS_ZV) + (row0 + 16 * w) * D) + lane;
            v4u xa = p[0], xb = p[64];
            for (int i = 0; i < 16; ++i) {
                const v4u ca = xa, cb = xb;
                if (i + 1 < 16) { xa = p[(size_t)(i + 1) * 128]; xb = p[(size_t)(i + 1) * 128 + 64]; }
                float s = 0.f, ss = 0.f; v4u oa, ob;
#pragma unroll
                for (int q = 0; q < 4; ++q) { const f32x2 ya = gelu_pk((f32x2){bflo(ca[q]), bfhi(ca[q])}), yb = gelu_pk((f32x2){bflo(cb[q]), bfhi(cb[q])});
                    s += (ya.x + ya.y) + (yb.x + yb.y); ss += (ya.x * ya.x + ya.y * ya.y) + (yb.x * yb.x + yb.y * yb.y); oa[q] = pk2(ya.x, ya.y); ob[q] = pk2(yb.x, yb.y); }
                p[(size_t)i * 128] = oa; p[(size_t)i * 128 + 64] = ob;
                s = wave_sum(s); ss = wave_sum(ss);
                const float mean = s * (1.f / D), var = ss * (1.f / D) - mean * mean;
                if (lane == 0) { *(LAS float*)(L + GM_MU + (16 * w + i) * 4) = mean; *(LAS float*)(L + GM_RS + (16 * w + i) * 4) = __builtin_amdgcn_rsqf(var + LN_EPS); }
            }
        }
        __syncthreads();
        TSEG(20);
        float mu[4], rs[4];
#pragma unroll
        for (int q = 0; q < 4; ++q) { mu[q] = *(const LAS float*)(L + GM_MU + (orow + 32 * q) * 4); rs[q] = *(const LAS float*)(L + GM_RS + (orow + 32 * q) * 4); }
        const GAS v4u* gv = (const GAS v4u*)((const bf16*)(F.ws + WS_ZV) + (row0 + orow) * D) + och;
        const bf16* wsg = (const bf16*)(F.ws + WS_WSG) + (size_t)(16 * w + fr) * 128 + 8 * g4;
        v4u xv[4], xu[4]; bf16x8 af[4];
#define GM_LOAD_V(gq_) do { _Pragma("unroll") for (int q = 0; q < 4; ++q) xv[q] = gv[(size_t)q * 32 * 128 + (gq_) * 16]; } while (0)
#define GM_LOAD_A(gq_) do { _Pragma("unroll") for (int kk = 0; kk < 4; ++kk) af[kk] = *(const GAS bf16x8*)(wsg + (size_t)(gq_) * 128 * 128 + 32 * kk); } while (0)
        GM_LOAD_V(0); GM_LOAD_A(0);
        for (int gq = 0; gq < 8; ++gq) {
            GAS v4u* gu = (GAS v4u*)((bf16*)(F.ws + WS_ZU) + (row0 + orow) * D + gq * 128) + och;
#pragma unroll
            for (int q = 0; q < 4; ++q) xu[q] = gu[(size_t)q * 32 * 128];
            const f32x4 bs = *(const GAS f32x4*)(F.in[I_GBS] + gq * 128 + 16 * w + 4 * g4);
            {
                const f32x4 lwa = *(const LAS f32x4*)(L + GM_LNW + (gq * 128 + 8 * och) * 4), lwb = *(const LAS f32x4*)(L + GM_LNW + (gq * 128 + 8 * och + 4) * 4);
                const f32x4 lba = *(const LAS f32x4*)(L + GM_LNB + (gq * 128 + 8 * och) * 4), lbb = *(const LAS f32x4*)(L + GM_LNB + (gq * 128 + 8 * och + 4) * 4);
#pragma unroll
                for (int q = 0; q < 4; ++q) { v4u o;
#pragma unroll
                    for (int e = 0; e < 4; ++e) { const float lw0 = e < 2 ? lwa[2 * e] : lwb[2 * e - 4], lw1 = e < 2 ? lwa[2 * e + 1] : lwb[2 * e - 3], lb0 = e < 2 ? lba[2 * e] : lbb[2 * e - 4], lb1 = e < 2 ? lba[2 * e + 1] : lbb[2 * e - 3];
                        o[e] = pk2((bflo(xv[q][e]) - mu[q]) * rs[q] * lw0 + lb0, (bfhi(xv[q][e]) - mu[q]) * rs[q] * lw1 + lb1); }
                    *(LAS v4u*)(L + GM_VN + offb(orow + 32 * q, och)) = o; }
            }
            if (gq + 1 < 8) GM_LOAD_V(gq + 1);
            __syncthreads();
            TSEG(21);
            f32x4 acc[8];
#pragma unroll
            for (int cb = 0; cb < 8; ++cb) acc[cb] = (f32x4){0.f, 0.f, 0.f, 0.f};
#pragma unroll
            for (int kk = 0; kk < 4; ++kk) {
                if (w < 4 && kk >= 2) continue;
#pragma unroll
                for (int hf = 0; hf < 2; ++hf) {
                    bf16x4 blo[4], bhi[4];
#pragma unroll
                    for (int c4 = 0; c4 < 4; ++c4) { TR_READ(blo[c4], lds_addr(L + GM_VN) + tr_off(lane, 4 * hf + c4, kk, 0)); TR_READ(bhi[c4], lds_addr(L + GM_VN) + tr_off(lane, 4 * hf + c4, kk, 1)); }
                    TR_WAIT();
#pragma unroll
                    for (int c4 = 0; c4 < 4; ++c4) acc[4 * hf + c4] = __builtin_amdgcn_mfma_f32_16x16x32_bf16(af[kk], TR_CAT(blo[c4], bhi[c4]), acc[4 * hf + c4], 0, 0, 0);
                }
            }
            if (gq + 1 < 8) GM_LOAD_A(gq + 1);
#pragma unroll
            for (int cb = 0; cb < 8; ++cb)
#pragma unroll
                for (int r = 0; r < 4; ++r) *(LAS unsigned short*)(L + GM_O + offb(16 * w + 4 * g4 + r, 2 * cb + (fr >> 3)) + 2 * (fr & 7)) = (unsigned short)(pk2(acc[cb][r] + bs[r], 0.f) & 0xffffu);
            __syncthreads();
            TSEG(22);
#pragma unroll
            for (int q = 0; q < 4; ++q) { const v4u sv = *(const LAS v4u*)(L + GM_O + offb(orow + 32 * q, och)); v4u o;
#pragma unroll
                for (int e = 0; e < 4; ++e) { const f32x2 gl = gelu_pk((f32x2){bflo(xu[q][e]), bfhi(xu[q][e])}); o[e] = pk2(gl.x * bflo(sv[e]), gl.y * bfhi(sv[e])); }
                gu[(size_t)q * 32 * 128] = o; }
            TSEG(23);
        }
#undef GM_LOAD_V
#undef GM_LOAD_A
    }
}

__device__ __forceinline__ void ln_mid_phase(Frame& F) {
    LAS float* tab = (LAS float*)(F.lds + RING_OFF);
    for (int wg = blockIdx.x; wg < M / 128; wg += F.G) {
        const int b = wg / (SEQ / 128);
        __syncthreads();
        const float* mod = (const float*)(F.ws + WS_MOD) + (size_t)b * 6144;
        for (int idx = F.tid; idx < 1024; idx += NWAVES * 64) { tab[idx] = F.in[I_LN1W][idx]; tab[1024 + idx] = F.in[I_LN1B][idx]; tab[2048 + idx] = mod[3072 + idx]; tab[3072 + idx] = 1.f + mod[4096 + idx]; tab[4096 + idx] = mod[2048 + idx]; }
        __syncthreads();
        const size_t rowb = (size_t)wg * 128 + F.wave * 16;
        const GAS f32x4* xb = (const GAS f32x4*)(F.in[I_X] + rowb * D) + F.lane;
        const GAS v2u* yb = (const GAS v2u*)((const bf16*)(F.ws + WS_MIXO) + rowb * D) + F.lane;
        f32x4 nx[4]; v2u ny[4];
#pragma unroll
        for (int j = 0; j < 4; ++j) { nx[j] = xb[64 * j]; ny[j] = yb[64 * j]; }
        for (int i = 0; i < 16; ++i) {
            const size_t row = rowb + i;
            GAS f32x4* hr = (GAS f32x4*)((float*)(F.ws + WS_H1) + row * D) + F.lane;
            f32x4 v[4]; float s = 0.f;
#pragma unroll
            for (int j = 0; j < 4; ++j) { const f32x4 g1 = *(const LAS f32x4*)(tab + 4096 + 4 * F.lane + 256 * j);
                v[j] = nx[j] * ALPHA + g1 * (f32x4){bflo(ny[j].x), bfhi(ny[j].x), bflo(ny[j].y), bfhi(ny[j].y)}; s += (v[j].x + v[j].y) + (v[j].z + v[j].w); }
            if (i + 1 < 16) {
#pragma unroll
                for (int j = 0; j < 4; ++j) { nx[j] = xb[(size_t)(i + 1) * 256 + 64 * j]; ny[j] = yb[(size_t)(i + 1) * 256 + 64 * j]; }
            }
            float mean = wave_sum(s) * (1.f / D), s2 = 0.f;
#pragma unroll
            for (int j = 0; j < 4; ++j) { v[j] = v[j] - mean; s2 += (v[j].x * v[j].x + v[j].y * v[j].y) + (v[j].z * v[j].z + v[j].w * v[j].w); }
            float rstd = __builtin_amdgcn_rsqf(wave_sum(s2) * (1.f / D) + LN_EPS);
            s = 0.f;
#pragma unroll
            for (int j = 0; j < 4; ++j) { const f32x4 lw = *(const LAS f32x4*)(tab + 4 * F.lane + 256 * j), lb = *(const LAS f32x4*)(tab + 1024 + 4 * F.lane + 256 * j);
                v[j] = v[j] * rstd * lw + lb; hr[64 * j] = v[j]; s += (v[j].x + v[j].y) + (v[j].z + v[j].w); }
            mean = wave_sum(s) * (1.f / D); s2 = 0.f;
#pragma unroll
            for (int j = 0; j < 4; ++j) { v[j] = v[j] - mean; s2 += (v[j].x * v[j].x + v[j].y * v[j].y) + (v[j].z * v[j].z + v[j].w * v[j].w); }
            rstd = __builtin_amdgcn_rsqf(wave_sum(s2) * (1.f / D) + LN_EPS);
            GAS v2u* o8 = (GAS v2u*)((bf16*)(F.ws + WS_U) + row * D) + F.lane;
#pragma unroll
            for (int j = 0; j < 4; ++j) { const f32x4 sh = *(const LAS f32x4*)(tab + 2048 + 4 * F.lane + 256 * j), sc = *(const LAS f32x4*)(tab + 3072 + 4 * F.lane + 256 * j);
                const f32x4 y = v[j] * rstd * sc + sh; o8[64 * j] = (v2u){pk2(y.x, y.y), pk2(y.z, y.w)}; }
        }
    }
}
__device__ __forceinline__ void ln_out_phase(Frame& F) {
    LAS float* tab = (LAS float*)(F.lds + RING_OFF);
    for (int wg = blockIdx.x; wg < M / 128; wg += F.G) {
        const int b = wg / (SEQ / 128);
        __syncthreads();
        const float* mod = (const float*)(F.ws + WS_MOD) + (size_t)b * 6144;
        for (int idx = F.tid; idx < 1024; idx += NWAVES * 64) { tab[idx] = F.in[I_LN2W][idx]; tab[1024 + idx] = F.in[I_LN2B][idx]; tab[2048 + idx] = mod[5120 + idx]; }
        __syncthreads();
        const size_t rowb = (size_t)wg * 128 + F.wave * 16;
        const GAS f32x4* hb = (const GAS f32x4*)((const float*)(F.ws + WS_H1) + rowb * D) + F.lane;
        const GAS v2u* yb = (const GAS v2u*)((const bf16*)(F.ws + WS_U) + rowb * D) + F.lane;
        f32x4 nh[4]; v2u ny[4];
#pragma unroll
        for (int j = 0; j < 4; ++j) { nh[j] = hb[64 * j]; ny[j] = yb[64 * j]; }
        for (int i = 0; i < 16; ++i) {
            f32x4 v[4]; float s = 0.f;
#pragma unroll
            for (int j = 0; j < 4; ++j) { const f32x4 g2 = *(const LAS f32x4*)(tab + 2048 + 4 * F.lane + 256 * j);
                v[j] = nh[j] * ALPHA + g2 * (f32x4){bflo(ny[j].x), bfhi(ny[j].x), bflo(ny[j].y), bfhi(ny[j].y)}; s += (v[j].x + v[j].y) + (v[j].z + v[j].w); }
            if (i + 1 < 16) {
#pragma unroll
                for (int j = 0; j < 4; ++j) { nh[j] = hb[(size_t)(i + 1) * 256 + 64 * j]; ny[j] = yb[(size_t)(i + 1) * 256 + 64 * j]; }
            }
            const float mean = wave_sum(s) * (1.f / D); float s2 = 0.f;
#pragma unroll
            for (int j = 0; j < 4; ++j) { v[j] = v[j] - mean; s2 += (v[j].x * v[j].x + v[j].y * v[j].y) + (v[j].z * v[j].z + v[j].w * v[j].w); }
            const float rstd = __builtin_amdgcn_rsqf(wave_sum(s2) * (1.f / D) + LN_EPS);
            GAS f32x4* orow = (GAS f32x4*)(F.out + (rowb + i) * D) + F.lane;
#pragma unroll
            for (int j = 0; j < 4; ++j) { const f32x4 lw = *(const LAS f32x4*)(tab + 4 * F.lane + 256 * j), lb = *(const LAS f32x4*)(tab + 1024 + 4 * F.lane + 256 * j); orow[64 * j] = v[j] * rstd * lw + lb; }
        }
    }
}

struct Args { const float* in[21]; float* out; unsigned char* ws; int ph_lo, ph_hi, li, pad; };
__global__ void __launch_bounds__(NWAVES * 64, 2) mk_fwd(Args args) {
    extern __shared__ __attribute__((aligned(16))) unsigned char lds[];
    Frame F;
    F.lds = (LAS unsigned char*)lds;
    F.MISC = (volatile LAS unsigned*)(F.lds + MISC_OFF);
    F.tid = threadIdx.x; F.lane = F.tid & 63; F.wave = __builtin_amdgcn_readfirstlane(F.tid >> 6);
    F.G = gridDim.x; { const int bx = blockIdx.x; F.vcu = (F.G % 8 == 0) ? (bx % 8) * (F.G / 8) + bx / 8 : bx; }
    F.ws = args.ws; F.out = args.out; F.ctl = (gu32*)(args.ws + WS_CTL); F.tacc = 0ull; F.tlast = 0ull;
#pragma unroll
    for (int i = 0; i < 21; ++i) F.in[i] = args.in[i];
    for (int u = F.tid; u < (LDS_BYTES - LDSCTL_OFF) / 4; u += NWAVES * 64) ((LAS unsigned*)(F.lds + LDSCTL_OFF))[u] = 0u;
    __syncthreads();
    XcdBarrier bar; bar.bar = (unsigned*)(F.ctl + CW_BAR); bar.x = 0; bar.st = nullptr;
    if (N_LAUNCHES != PER_PHASE) bar = xcd_barrier_post((unsigned*)(F.ctl + CW_BAR) + args.li * XCD_BAR_WORDS, F.MISC + 8);
#define GRID_BAR(seam) do { if (N_LAUNCHES == PER_PHASE) { if (F.tid == 0) __hip_atomic_store(F.ctl + CW_TMO, 0xBADBA0u | (unsigned)(seam), RLX_AGENT); } else { xcd_barrier(bar); } } while (0)
    const int lo = args.ph_lo, hi = args.ph_hi;
#define IN(k) (lo <= (k) && (k) < hi)
#define BOTH(k) (IN(k) && IN((k) + 1))

    unsigned long long tp_lo = 0ull, tp_hi = 0ull;
#define STAMP(i) do { if (MK_TP_LO >= 0 && blockIdx.x == 0 && F.tid == 0) { if ((i) == MK_TP_LO) tp_lo = __builtin_amdgcn_s_memrealtime(); if ((i) == MK_TP_HI) tp_hi = __builtin_amdgcn_s_memrealtime(); } } while (0)
    STAMP(0);
#define REP(k) for (int rep_ = 0; rep_ < ((MK_REPEAT == (k)) ? 2 : 1); ++rep_)
#define REPBAR(k) do { if (MK_REPEAT == (k) && rep_ == 0) GRID_BAR(k); } while (0)
    if (IN(0)) { REP(0) { p0_prologue(F); REPBAR(0); } if (BOTH(0)) GRID_BAR(0); STAMP(1); }
    if (IN(1)) { REP(1) { p1_adaln_in(F); REPBAR(1); } if (BOTH(1)) GRID_BAR(1); STAMP(2); }
    if (IN(2)) {
        REP(2) {
        pg8::SchedPlain S; S.init(F.ws + WS_U, F.ws + WS_WIN, M, NZ, D, F.G, (int)blockIdx.x);
        EpiZ E{(bf16*)(F.ws + WS_ZQ), (bf16*)F.out, F.in[I_BGATE]};
        pg8::gemm_phase<EpiZ, pg8::SchedPlain>(F.lds + RING_OFF, D, S, E);
        REPBAR(2); }
        if (BOTH(2)) GRID_BAR(2); STAMP(3);
    }
    if (IN(3)) { hgrn_local_states<0>(F); GRID_BAR(3); STAMP(12); hgrn_scan_states(F); gmlp_phase(F); if (BOTH(3)) GRID_BAR(3); STAMP(4); }
    if (IN(4)) {
        unsigned long long tb0 = 0ull; if ((MK_TACC == 10 || MK_TACC == 11) && F.tid == 0) tb0 = __builtin_amdgcn_s_memrealtime();
        REP(4) { hgrn_outputs(F); REPBAR(4); }
        if ((MK_TACC == 10 || MK_TACC == 11) && F.tid == 0) { const unsigned dt = (unsigned)(__builtin_amdgcn_s_memrealtime() - tb0); atomicMax((unsigned*)(F.ctl + 8), MK_TACC == 10 ? dt : 1000000u - dt); }
        if (BOTH(4)) GRID_BAR(4); STAMP(5);
        if ((MK_TACC == 10 || MK_TACC == 11) && blockIdx.x == 0 && F.tid == 0) { const unsigned v = __hip_atomic_load((unsigned*)(F.ctl + 8), RLX_AGENT); F.tacc = MK_TACC == 10 ? v : 1000000u - v; }
    }
    if (IN(5)) {
        REP(5) {
        pg8::SchedPair S; S.init(F.ws + WS_HG, F.ws + WS_WA, F.ws + WS_ZU, F.ws + WS_WB, M, D, D, F.G, (int)blockIdx.x);
        EpiProj E{(const bf16*)F.out, (const bf16*)F.out + (size_t)M * D, (bf16*)(F.ws + WS_MIX)};
        pg8::gemm_phase<EpiProj, pg8::SchedPair>(F.lds + RING_OFF, D, S, E);
        REPBAR(5); }
        if (BOTH(5)) GRID_BAR(5); STAMP(6);
    }
    if (IN(6)) {
        REP(6) {
        pg8::SchedPlain S; S.init(F.ws + WS_MIX, F.ws + WS_WO, M, D, D, F.G, (int)blockIdx.x);
        EpiBf E{(bf16*)(F.ws + WS_MIXO)};
        pg8::gemm_phase<EpiBf, pg8::SchedPlain>(F.lds + RING_OFF, D, S, E);
        REPBAR(6); }
        if (BOTH(6)) GRID_BAR(6); STAMP(7);
    }
    if (IN(7)) { REP(7) { ln_mid_phase(F); REPBAR(7); } if (BOTH(7)) GRID_BAR(7); STAMP(8); }
    if (IN(8)) {
        REP(8) {
        pg8::SchedPlain S; S.init(F.ws + WS_U, F.ws + WS_WF1, M, NF1, D, F.G, (int)blockIdx.x);
        EpiSwiGLU E{(bf16*)(F.ws + WS_ACT)};
        pg8::gemm_phase<EpiSwiGLU, pg8::SchedPlain>(F.lds + RING_OFF, D, S, E);
        REPBAR(8); }
        if (BOTH(8)) GRID_BAR(8); STAMP(9);
    }
    if (IN(9)) {
        REP(9) {
        pg8::SchedPlain S; S.init(F.ws + WS_ACT, F.ws + WS_WF2, M, D, DFF, F.G, (int)blockIdx.x);
        EpiBf E{(bf16*)(F.ws + WS_U)};
        pg8::gemm_phase<EpiBf, pg8::SchedPlain>(F.lds + RING_OFF, DFF, S, E);
        REPBAR(9); }
        if (BOTH(9)) GRID_BAR(9); STAMP(10);
    }
    if (IN(10)) { ln_out_phase(F); }
    STAMP(11);
    if (MK_TACC >= 0 && blockIdx.x == 0 && F.tid == 0) { const unsigned long long t0 = __builtin_amdgcn_s_memrealtime(), dt = 4ull * F.tacc; while (__builtin_amdgcn_s_memrealtime() - t0 < dt) __builtin_amdgcn_s_sleep(8); }
    if (MK_TP_LO >= 0 && blockIdx.x == 0 && F.tid == 0) { const unsigned long long t0 = __builtin_amdgcn_s_memrealtime(), dt = 4ull * (tp_hi - tp_lo); while (__builtin_amdgcn_s_memrealtime() - t0 < dt) __builtin_amdgcn_s_sleep(8); }
#undef REP
#undef REPBAR
#undef IN
#undef BOTH
}

extern "C" void kernel_launch(void* const* d_in, const int* in_sizes, int n_in, void* d_out, int out_size, void* d_ws, size_t ws_size, hipStream_t stream) {
    static int grid = 0;
    if (grid == 0) {
        if (n_in != 21 || in_sizes[0] != M * D || out_size != M * D || ws_size < WS_END) { fprintf(stderr, "kernel_launch: unexpected shapes (n_in %d, in0 %d, out %d, ws %zu); nothing launched\n", n_in, n_in > 0 ? in_sizes[0] : -1, out_size, ws_size); grid = -1; return; }
        int dev = 0, cus = 0, per_cu = 0;
        if (hipGetDevice(&dev) != hipSuccess || hipDeviceGetAttribute(&cus, hipDeviceAttributeMultiprocessorCount, dev) != hipSuccess) { grid = -1; return; }
        if (hipFuncSetAttribute((const void*)mk_fwd, hipFuncAttributeMaxDynamicSharedMemorySize, LDS_BYTES) != hipSuccess) { fprintf(stderr, "kernel_launch: hipFuncSetAttribute failed\n"); grid = -1; return; }
        if (hipOccupancyMaxActiveBlocksPerMultiprocessor(&per_cu, (const void*)mk_fwd, NWAVES * 64, LDS_BYTES) != hipSuccess || per_cu < 1) fprintf(stderr, "kernel_launch: occupancy query reports %d workgroups per CU\n", per_cu);
        (void)hipGetLastError();
        grid = cus;
    }
    if (grid < 0) return;
    if (hipMemsetAsync((char*)d_ws + WS_CTL, 0, CTL_ZERO_BYTES, stream) != hipSuccess) return;
    Args a{};
    for (int i = 0; i < 21; ++i) a.in[i] = (const float*)d_in[i];
    a.out = (float*)d_out; a.ws = (unsigned char*)d_ws;
    for (int li = 0; li < N_LAUNCHES; ++li) {
        if (N_LAUNCHES == PER_PHASE) { a.ph_lo = li; a.ph_hi = li + 1; } else { a.ph_lo = 0; a.ph_hi = PER_PHASE; }
        a.li = (N_LAUNCHES == PER_PHASE) ? 0 : li;
        hipLaunchKernelGGL(mk_fwd, dim3(grid), dim3(NWAVES * 64), LDS_BYTES, stream, a);
        if (hipPeekAtLastError() != hipSuccess) { fprintf(stderr, "kernel_launch: launch %d failed\n", li); break; }
    }
}
```
